# Optimizing an MI355X kernel written in HIP

```python
import jax, jax.numpy as jnp
from jax import lax
import numpy as np

D_MODEL = 2048
BATCH = 2
SEQ = 4096
DEPTH = 1

MIX_WIDTH = D_MODEL
GLA_HEADS = 4
GLA_VALUE_DIM = MIX_WIDTH // 2
GLA_KEY_DIM = GLA_VALUE_DIM // 2
GLA_HEAD_K = GLA_KEY_DIM // GLA_HEADS
GLA_HEAD_V = GLA_VALUE_DIM // GLA_HEADS
GLA_GATE_RANK = 16
GLA_GATE_NORMALIZER = 16.0
HG_WIDTH = MIX_WIDTH - GLA_VALUE_DIM
HG_EXPAND = 128
HG_HEADS = HG_WIDTH // HG_EXPAND
HG_HEAD_V = HG_WIDTH // HG_HEADS
HG_FORGET_DIM = HG_HEADS * HG_EXPAND
IN_WIDTH = 2 * GLA_KEY_DIM + 2 * GLA_VALUE_DIM + GLA_GATE_RANK + 2 * HG_FORGET_DIM + 2 * HG_WIDTH
FFN_HIDDEN = -(-8 * D_MODEL // (3 * 256)) * 256
CHUNK = 64
NORM_EPS = 1e-6

kernel_name = "hymba_gla_hgrn2_adaln_block"


def rms_norm(x, w):
    xf = x.astype(jnp.float32)
    y = xf * lax.rsqrt(jnp.mean(xf * xf, axis=-1, keepdims=True) + NORM_EPS)
    return (y * w.astype(jnp.float32)).astype(x.dtype)


def chunk_gated_linear_attention(q, k, v, log_g, scale):
    B, T, H, Dk = q.shape
    Dv = v.shape[-1]
    N = T // CHUNK

    def to_chunks(a):
        return a.astype(jnp.float32).reshape(B, N, CHUNK, H, a.shape[-1]).transpose(1, 0, 3, 2, 4)

    qc, kc, vc, gc = to_chunks(q * scale), to_chunks(k), to_chunks(v), to_chunks(log_g)
    causal = jnp.tril(jnp.ones((CHUNK, CHUNK), dtype=bool))[:, :, None]

    def step(S, inp):
        qi, ki, vi, gi = inp
        b = jnp.cumsum(gi, axis=-2)
        b_last = b[..., -1:, :]
        o_inter = jnp.einsum('bhcd,bhde->bhce', qi * jnp.exp(b), S)
        diff = b[..., :, None, :] - b[..., None, :, :]
        decay = jnp.exp(jnp.where(causal, diff, -jnp.inf))
        scores = jnp.einsum('bhid,bhjd,bhijd->bhij', qi, ki, decay)
        o = o_inter + jnp.einsum('bhij,bhje->bhie', scores, vi)
        S_new = jnp.swapaxes(jnp.exp(b_last), -1, -2) * S + jnp.einsum(
            'bhcd,bhce->bhde', ki * jnp.exp(b_last - b), vi)
        return S_new, o

    S0 = jnp.zeros((B, H, Dk, Dv), jnp.float32)
    _, o = lax.scan(step, S0, (qc, kc, vc, gc))
    return o.transpose(1, 0, 3, 2, 4).reshape(B, T, H, Dv).astype(v.dtype)


def split_in_projection(p):
    sizes = (GLA_KEY_DIM, GLA_KEY_DIM, GLA_VALUE_DIM, GLA_VALUE_DIM, GLA_GATE_RANK,
             HG_FORGET_DIM, HG_FORGET_DIM, HG_WIDTH, HG_WIDTH)
    idx = np.cumsum(sizes)[:-1].tolist()
    return jnp.split(p, idx, axis=-1)


def hybrid_mixer(h, w_in, w_gla_gate, b_gla_gate, gla_norm_w, lb, hg_norm_w, w_out):
    B, T, _ = h.shape
    p = h @ w_in
    gla_q, gla_k, gla_v, gla_g, gla_lr, hg_q, hg_f, hg_i, hg_g = split_in_projection(p)

    log_alpha = jax.nn.log_sigmoid((gla_lr @ w_gla_gate + b_gla_gate).astype(jnp.float32)) / GLA_GATE_NORMALIZER
    o_gla = chunk_gated_linear_attention(
        gla_q.reshape(B, T, GLA_HEADS, GLA_HEAD_K),
        gla_k.reshape(B, T, GLA_HEADS, GLA_HEAD_K),
        gla_v.reshape(B, T, GLA_HEADS, GLA_HEAD_V),
        log_alpha.reshape(B, T, GLA_HEADS, GLA_HEAD_K),
        GLA_HEAD_K ** -0.5)
    o_gla = rms_norm(o_gla, gla_norm_w).reshape(B, T, GLA_VALUE_DIM) * jax.nn.silu(gla_g)

    f = lb + (1.0 - lb) * jax.nn.sigmoid(hg_f.astype(jnp.float32))
    o_hg = chunk_gated_linear_attention(
        jax.nn.silu(hg_q).reshape(B, T, HG_HEADS, HG_EXPAND),
        (1.0 - f).reshape(B, T, HG_HEADS, HG_EXPAND),
        hg_i.reshape(B, T, HG_HEADS, HG_HEAD_V),
        jnp.log(f).reshape(B, T, HG_HEADS, HG_EXPAND),
        1.0)
    o_hg = rms_norm(o_hg, hg_norm_w).reshape(B, T, HG_WIDTH) * jax.nn.silu(hg_g)

    return jnp.concatenate([o_gla, o_hg], axis=-1) @ w_out


def swiglu(h, w_ffn_in, w_ffn_out):
    a, u = jnp.split(h @ w_ffn_in, 2, axis=-1)
    return (jax.nn.silu(a) * u) @ w_ffn_out


def setup_inputs(seed: int = 0) -> dict:
    key = jax.random.key(seed)
    ks = jax.random.split(key, 18)

    def nrm(k, shape, s):
        return jax.random.normal(k, shape, jnp.float32) * s

    return {
        "x": nrm(ks[0], (BATCH, SEQ, D_MODEL), 1.0),
        "c": nrm(ks[1], (BATCH, D_MODEL), 1.0),
        "w_ada": nrm(ks[2], (DEPTH, D_MODEL, 6 * D_MODEL), 0.5 * D_MODEL ** -0.5),
        "b_ada": nrm(ks[3], (DEPTH, 6 * D_MODEL), 0.01),
        "norm_mix_w": 1.0 + nrm(ks[4], (DEPTH, D_MODEL), 0.02),
        "w_in": nrm(ks[5], (DEPTH, D_MODEL, IN_WIDTH), D_MODEL ** -0.5),
        "w_gla_gate": nrm(ks[6], (DEPTH, GLA_GATE_RANK, GLA_KEY_DIM), GLA_GATE_RANK ** -0.5),
        "b_gla_gate": nrm(ks[7], (DEPTH, GLA_KEY_DIM), 0.1),
        "gla_norm_w": 1.0 + nrm(ks[8], (DEPTH, GLA_HEAD_V), 0.02),
        "hg_lower_bound_logits": nrm(ks[9], (DEPTH + 1, HG_FORGET_DIM), 0.1),
        "hg_norm_w": 1.0 + nrm(ks[10], (DEPTH, HG_HEAD_V), 0.02),
        "w_out": nrm(ks[11], (DEPTH, MIX_WIDTH, D_MODEL), MIX_WIDTH ** -0.5),
        "norm_ffn_w": 1.0 + nrm(ks[12], (DEPTH, D_MODEL), 0.02),
        "w_ffn_in": nrm(ks[13], (DEPTH, D_MODEL, 2 * FFN_HIDDEN), D_MODEL ** -0.5),
        "w_ffn_out": nrm(ks[14], (DEPTH, FFN_HIDDEN, D_MODEL), FFN_HIDDEN ** -0.5),
        "final_norm_w": 1.0 + nrm(ks[15], (D_MODEL,), 0.02),
    }


def reference(x, c, w_ada, b_ada, norm_mix_w, w_in, w_gla_gate, b_gla_gate, gla_norm_w,
              hg_lower_bound_logits, hg_norm_w, w_out, norm_ffn_w, w_ffn_in, w_ffn_out,
              final_norm_w):
    lb_all = jnp.cumsum(jax.nn.softmax(hg_lower_bound_logits.astype(jnp.float32), axis=0), axis=0)[:DEPTH]
    c_act = jax.nn.silu(c)
    for l in range(DEPTH):
        mod = c_act @ w_ada[l] + b_ada[l]
        shift_m, scale_m, gate_m, shift_f, scale_f, gate_f = jnp.split(mod[:, None, :], 6, axis=-1)
        h = rms_norm(x, norm_mix_w[l]) * (1.0 + scale_m) + shift_m
        y = hybrid_mixer(h, w_in[l], w_gla_gate[l], b_gla_gate[l], gla_norm_w[l], lb_all[l],
                         hg_norm_w[l], w_out[l])
        x = x + gate_m * y
        h = rms_norm(x, norm_ffn_w[l]) * (1.0 + scale_f) + shift_f
        x = x + gate_f * swiglu(h, w_ffn_in[l], w_ffn_out[l])
    return rms_norm(x, final_norm_w)
```

```cpp
#include <hip/hip_runtime.h>
#include <hip/hip_cooperative_groups.h>
#include <cstdio>
#include <cstdint>
namespace cg = cooperative_groups;
namespace pg8 {
#define PG8_LAS __attribute__((address_space(3)))
typedef unsigned short bf16_t;
typedef short bf16x8 __attribute__((ext_vector_type(8)));
typedef float f32x4 __attribute__((ext_vector_type(4)));
typedef unsigned u32x4 __attribute__((ext_vector_type(4)));
constexpr int BM = 256, BK = 64, HALF = 128, HTB = HALF * BK * 2  , STAGE_BYTES = 8 * HTB, NXCD = 8, WGM = 8;

__host__ __device__ __forceinline__ int lds_byte(int r, int c) { const int st = (r >> 4) * 2 + (c >> 5), rr = r & 15, cc = c & 31, ob = rr * 64 + cc * 2; return st * 1024 + (ob ^ (((ob >> 9) & 1) << 5)); }
__host__ __device__ __forceinline__ void stage_rc(int b, int& R, int& C) { const int st = b / 1024, sb = b % 1024, swz = sb ^ (((sb >> 9) & 1) << 5); R = (st >> 1) * 16 + swz / 64; C = (st & 1) * 32 + (swz % 64) / 2; }
__host__ __device__ __forceinline__ int perm32(int rho) { const int n = rho >> 4, i = rho & 15; return 8 * (i >> 2) + 4 * n + (i & 3); }

struct Unit { int pm, pn; };
struct Gemm { const bf16_t* A; const bf16_t* Bt; int M, N, K; unsigned swap; };

struct StaticOrder {
    int nM, nN, nwg, G, c;
    __host__ __device__ void init(int M, int N, int G_, int c_) { nM = M / BM; nN = N / BM; nwg = nM * nN; G = G_; c = c_; }
    __host__ __device__ bool next(int i, Unit& u) const {
        const long L = (long)i * G + c; if (L >= nwg) return false;
        int wgid = (int)L; { const int q = nwg / NXCD, r = nwg % NXCD, xcd = wgid % NXCD, off = wgid / NXCD; wgid = (xcd < r ? xcd * (q + 1) : r * (q + 1) + (xcd - r) * q) + off; }
        const int nig = WGM * nN, gid = wgid / nig, fm = gid * WGM, gsz = (nM - fm) < WGM ? (nM - fm) : WGM;
        u.pm = fm + ((wgid % nig) % gsz); u.pn = (wgid % nig) / gsz; return true;
    }
    __device__ __forceinline__ void a_ready(const Unit&) const {}
    __device__ __forceinline__ void done(const Unit&) const {}
};

__device__ __forceinline__ unsigned cvt_pk_bf16(float lo, float hi) { unsigned r; asm volatile("v_cvt_pk_bf16_f32 %0, %1, %2" : "=v"(r) : "v"(lo), "v"(hi)); return r; }
typedef float f32x2 __attribute__((ext_vector_type(2)));
__device__ __forceinline__ float silu_f(float x) { return x / (1.0f + __expf(-x)); }
__device__ __forceinline__ float logsig_f(float x) { return fminf(x, 0.f) - __logf(1.0f + __expf(-fabsf(x))); }

constexpr int MTOK_ = 8192;
struct EpiInProj {
    static constexpr bool PERM = true, AFTER_DRAIN = false;
    bf16_t* QT; bf16_t* KT; bf16_t* VT; float* GT; bf16_t* GG; const float* bgate; const float* lbl;
    __device__ __forceinline__ void operator()(const f32x4 (&acc)[2][2][4][2], const Unit& u, int wr, int wc, int fr, int fq) const {
        const int pn = u.pn;
        int type; bf16_t* dst; int rowoff; float scale = 1.0f;
        if (pn < 2)       { type = 0; dst = QT; rowoff = 256 * pn; scale = 0.08838834764831845f; }
        else if (pn < 4)  { type = 0; dst = KT; rowoff = 256 * (pn - 2); }
        else if (pn < 8)  { type = 0; dst = VT; rowoff = 256 * (pn - 4); }
        else if (pn < 12) { type = 4; dst = GG; rowoff = 256 * (pn - 8); }
        else if (pn < 14) { type = 2; dst = nullptr; rowoff = 256 * (pn - 12); }
        else if (pn < 18) { type = 1; dst = QT; rowoff = 512 + 256 * (pn - 14); }
        else if (pn < 22) { type = 3; dst = KT; rowoff = 512 + 256 * (pn - 18); }
        else if (pn < 26) { type = 0; dst = VT; rowoff = 1024 + 256 * (pn - 22); }
        else              { type = 4; dst = GG; rowoff = 1024 + 256 * (pn - 26); }
        if (type == 4) {
            const int row0 = u.pm * BM + wr * 64 + fr, col0 = rowoff + wc * 32 + 8 * fq;
#pragma unroll
            for (int ai = 0; ai < 2; ++ai)
#pragma unroll
                for (int m = 0; m < 4; ++m) { bf16_t* rowp = GG + (size_t)(row0 + ai * HALF + m * 16) * 2048 + col0;
#pragma unroll
                    for (int bj = 0; bj < 2; ++bj) { const f32x4 v0 = acc[ai][bj][m][0], v1 = acc[ai][bj][m][1]; u32x4 w;
                        w.x = cvt_pk_bf16(silu_f(v0[0]), silu_f(v0[1])); w.y = cvt_pk_bf16(silu_f(v0[2]), silu_f(v0[3]));
                        w.z = cvt_pk_bf16(silu_f(v1[0]), silu_f(v1[1])); w.w = cvt_pk_bf16(silu_f(v1[2]), silu_f(v1[3]));
                        *(u32x4*)(rowp + bj * HALF) = w; } }
            return;
        }
        const int rl0 = wr * 64 + fr;
        const int col0 = u.pm * BM + wc * 32 + 8 * fq;
        if (type == 0 || type == 1) {
#pragma unroll
            for (int ai = 0; ai < 2; ++ai)
#pragma unroll
                for (int m = 0; m < 4; ++m) { bf16_t* rowp = dst + (size_t)(rowoff + rl0 + ai * HALF + m * 16) * MTOK_ + col0;
#pragma unroll
                    for (int bj = 0; bj < 2; ++bj) { f32x4 v0 = acc[ai][bj][m][0], v1 = acc[ai][bj][m][1]; u32x4 w;
                        if (type == 1) { v0 = (f32x4){silu_f(v0[0]), silu_f(v0[1]), silu_f(v0[2]), silu_f(v0[3])}; v1 = (f32x4){silu_f(v1[0]), silu_f(v1[1]), silu_f(v1[2]), silu_f(v1[3])}; }
                        else { v0 = v0 * scale; v1 = v1 * scale; }
                        w.x = cvt_pk_bf16(v0[0], v0[1]); w.y = cvt_pk_bf16(v0[2], v0[3]); w.z = cvt_pk_bf16(v1[0], v1[1]); w.w = cvt_pk_bf16(v1[2], v1[3]);
                        *(u32x4*)(rowp + bj * HALF) = w; } }
            return;
        }
        if (type == 2) {
#pragma unroll
            for (int ai = 0; ai < 2; ++ai)
#pragma unroll
                for (int m = 0; m < 4; ++m) { const int row = rowoff + rl0 + ai * HALF + m * 16; const float bias = bgate[row]; float* rowp = GT + (size_t)row * MTOK_ + col0;
#pragma unroll
                    for (int bj = 0; bj < 2; ++bj) { const f32x4 v0 = acc[ai][bj][m][0], v1 = acc[ai][bj][m][1];
                        *(f32x4*)(rowp + bj * HALF) = (f32x4){logsig_f(v0[0] + bias), logsig_f(v0[1] + bias), logsig_f(v0[2] + bias), logsig_f(v0[3] + bias)} * 0.0625f;
                        *(f32x4*)(rowp + bj * HALF + 4) = (f32x4){logsig_f(v1[0] + bias), logsig_f(v1[1] + bias), logsig_f(v1[2] + bias), logsig_f(v1[3] + bias)} * 0.0625f; } }
            return;
        }
#pragma unroll
        for (int ai = 0; ai < 2; ++ai)
#pragma unroll
            for (int m = 0; m < 4; ++m) { const int row = rowoff + rl0 + ai * HALF + m * 16; const int li = row - 512;
                const float lb = 1.0f / (1.0f + __expf(lbl[1024 + li] - lbl[li])), omlb = 1.0f - lb;
                bf16_t* krow = KT + (size_t)row * MTOK_ + col0; float* grow = GT + (size_t)row * MTOK_ + col0;
#pragma unroll
                for (int bj = 0; bj < 2; ++bj) { float kv[8], gv[8];
#pragma unroll
                    for (int n = 0; n < 2; ++n)
#pragma unroll
                        for (int e = 0; e < 4; ++e) { const float x = acc[ai][bj][m][n][e]; const float ex = __expf(-fabsf(x)); const float sp = 1.0f / (1.0f + ex);
                            const float sg = x >= 0.f ? sp : ex * sp, omsg = x >= 0.f ? ex * sp : sp;
                            kv[4 * n + e] = omlb * omsg; gv[4 * n + e] = __logf(lb + omlb * sg); }
                    u32x4 w; w.x = cvt_pk_bf16(kv[0], kv[1]); w.y = cvt_pk_bf16(kv[2], kv[3]); w.z = cvt_pk_bf16(kv[4], kv[5]); w.w = cvt_pk_bf16(kv[6], kv[7]);
                    *(u32x4*)(krow + bj * HALF) = w;
                    *(f32x4*)(grow + bj * HALF) = (f32x4){gv[0], gv[1], gv[2], gv[3]}; *(f32x4*)(grow + bj * HALF + 4) = (f32x4){gv[4], gv[5], gv[6], gv[7]}; } }
    }
};
struct EpiSwiGLU {
    static constexpr bool PERM = true, AFTER_DRAIN = false;
    bf16_t* O; int ldc;
    __device__ __forceinline__ void operator()(const f32x4 (&acc)[2][2][4][2], const Unit& u, int wr, int wc, int fr, int fq) const {
        const int row0 = u.pm * BM + wr * 64 + fr, col0 = u.pn * HALF + wc * 32 + 8 * fq;
#pragma unroll
        for (int ai = 0; ai < 2; ++ai)
#pragma unroll
            for (int m = 0; m < 4; ++m) { bf16_t* rowp = O + (size_t)(row0 + ai * HALF + m * 16) * ldc + col0;
                const f32x4 a0 = acc[ai][0][m][0], a1 = acc[ai][0][m][1], u0 = acc[ai][1][m][0], u1 = acc[ai][1][m][1]; u32x4 w;
                w.x = cvt_pk_bf16(silu_f(a0[0]) * u0[0], silu_f(a0[1]) * u0[1]); w.y = cvt_pk_bf16(silu_f(a0[2]) * u0[2], silu_f(a0[3]) * u0[3]);
                w.z = cvt_pk_bf16(silu_f(a1[0]) * u1[0], silu_f(a1[1]) * u1[1]); w.w = cvt_pk_bf16(silu_f(a1[2]) * u1[2], silu_f(a1[3]) * u1[3]);
                *(u32x4*)rowp = w; }
    }
};
struct EpiResid {
    static constexpr bool PERM = true, AFTER_DRAIN = false;
    const float* base; float* out; const float* gate;
    __device__ __forceinline__ void operator()(const f32x4 (&acc)[2][2][4][2], const Unit& u, int wr, int wc, int fr, int fq) const {
        const int row0 = u.pm * BM + wr * 64 + fr, col0 = u.pn * BM + wc * 32 + 8 * fq;
        const float* gp = gate + (size_t)(u.pm >> 4) * 12288 + col0;
        f32x4 gv[2][2];
#pragma unroll
        for (int bj = 0; bj < 2; ++bj)
#pragma unroll
            for (int n = 0; n < 2; ++n) gv[bj][n] = *(const f32x4*)(gp + bj * HALF + 4 * n);
#pragma unroll
        for (int ai = 0; ai < 2; ++ai)
#pragma unroll
            for (int m = 0; m < 4; ++m) { const size_t off = (size_t)(row0 + ai * HALF + m * 16) * 2048 + col0;
#pragma unroll
                for (int bj = 0; bj < 2; ++bj)
#pragma unroll
                    for (int n = 0; n < 2; ++n) { const f32x4 bs = *(const f32x4*)(base + off + bj * HALF + 4 * n);
                        *(f32x4*)(out + off + bj * HALF + 4 * n) = bs + gv[bj][n] * acc[ai][bj][m][n]; } }
    }
};
template <class Epi, class Sched, bool ALIGN_EPI = false, bool SP2 = false>
__device__ __forceinline__ void gemm_phase(PG8_LAS unsigned char* lds, const Gemm g, const Sched& S, const Epi& E) {
    const int tid = threadIdx.x, wid = __builtin_amdgcn_readfirstlane(tid >> 6), lane = tid & 63, wr = wid >> 2, wc = wid & 3, fr = lane & 15, fq = lane >> 4;
    const int K = g.K, nt = K / BK;
    unsigned voffA[2], voffB[2];
#pragma unroll
    for (int i = 0; i < 2; ++i) { int R, C; stage_rc(tid * 16 + i * 8192, R, C); const int Rb = Epi::PERM ? ((R & ~31) + perm32(R & 31)) : R;
        voffA[i] = (unsigned)(R * K + C) * 2u; voffB[i] = (unsigned)(Rb * K + C) * 2u; }
    const size_t kstep = (size_t)(BK * 2);
    const size_t hstep = (size_t)HALF * K * 2;
    const size_t tstep = 2 * hstep;
    const unsigned ldsw = (unsigned)wid * 1024u;
    const int aoff = lds_byte(wr * 64 + fr, fq * 8), boff = lds_byte(wc * 32 + fr, fq * 8);
#define PG8_SA(b, h) (((b) * 2 + (h)) * HTB)
#define PG8_SB(b, h) ((4 + (b) * 2 + (h)) * HTB)
#define PG8_STAGE(bufoff, gbase, voff) do { _Pragma("unroll") for (int _i = 0; _i < 2; ++_i) \
        __builtin_amdgcn_global_load_lds((const unsigned*)((const char*)(gbase) + (voff)[_i]), (PG8_LAS unsigned*)(lds + (bufoff) + ldsw + _i * 8192), 16, 0, 0); } while (0)
#define PG8_LDA(dst, b, h) do { _Pragma("unroll") for (int m = 0; m < 4; ++m) _Pragma("unroll") for (int k = 0; k < 2; ++k) dst[m][k] = *(const PG8_LAS bf16x8*)(lds + PG8_SA(b, h) + aoff + m * 2048 + k * 1024); } while (0)
#define PG8_LDB(dst, b, h) do { _Pragma("unroll") for (int n = 0; n < 2; ++n) _Pragma("unroll") for (int k = 0; k < 2; ++k) dst[n][k] = *(const PG8_LAS bf16x8*)(lds + PG8_SB(b, h) + boff + n * 2048 + k * 1024); } while (0)
#define PG8_MMA(ai, bj, At, Bt) do { __builtin_amdgcn_s_setprio(1); _Pragma("unroll") for (int m = 0; m < 4; ++m) _Pragma("unroll") for (int n = 0; n < 2; ++n) _Pragma("unroll") for (int k = 0; k < 2; ++k) \
        acc[ai][bj][m][n] = __builtin_amdgcn_mfma_f32_16x16x32_bf16(Bt[n][k], At[m][k], acc[ai][bj][m][n], 0, 0, 0); __builtin_amdgcn_s_setprio(0); } while (0)
#define PG8_WAIT_V(n) asm volatile("s_waitcnt vmcnt(" #n ")" ::: "memory")
#define PG8_WAIT_L(n) asm volatile("s_waitcnt lgkmcnt(" #n ")" ::: "memory")
#define PG8_BAR __builtin_amdgcn_s_barrier()
#define PG8_SCHED __builtin_amdgcn_sched_barrier(0)
    Unit cur, nxt; int ui = 0;
    if (!S.next(0, cur)) return;
    f32x4 acc[2][2][4][2];
#pragma unroll
    for (int a = 0; a < 2; ++a)
#pragma unroll
        for (int b = 0; b < 2; ++b)
#pragma unroll
            for (int m = 0; m < 4; ++m)
#pragma unroll
                for (int n = 0; n < 2; ++n) acc[a][b][m][n] = (f32x4){0.f, 0.f, 0.f, 0.f};
    bf16x8 At[4][2], B0[2][2], B1[2][2];
#define PG8_SW(u) (((u).pn < 32) && ((g.swap >> (u).pn) & 1u))
#define PG8_BASEA(u) (PG8_SW(u) ? (const char*)g.Bt + (size_t)(u).pn * tstep : (const char*)g.A + (size_t)(u).pm * tstep)
#define PG8_BASEB(u) (PG8_SW(u) ? (const char*)g.A + (size_t)(u).pm * tstep : (const char*)g.Bt + (size_t)(u).pn * tstep)
    const char* cA = PG8_BASEA(cur); const char* cB = PG8_BASEB(cur);
    S.a_ready(cur);
    if constexpr (SP2) {
        PG8_STAGE(PG8_SB(0, 0), cB, voffB); PG8_STAGE(PG8_SB(0, 1), cB + hstep, voffB); PG8_STAGE(PG8_SA(0, 0), cA, voffA); PG8_STAGE(PG8_SA(0, 1), cA + hstep, voffA);
        if (wr == 1) PG8_BAR;
        PG8_WAIT_V(2); PG8_BAR;
        PG8_STAGE(PG8_SB(1, 0), cB + kstep, voffB); PG8_STAGE(PG8_SA(1, 0), cA + kstep, voffA); PG8_STAGE(PG8_SB(1, 1), cB + hstep + kstep, voffB);
        PG8_WAIT_V(6); PG8_BAR;
    } else {
        PG8_STAGE(PG8_SB(0, 0), cB, voffB); PG8_STAGE(PG8_SA(0, 0), cA, voffA); PG8_STAGE(PG8_SB(0, 1), cB + hstep, voffB); PG8_STAGE(PG8_SA(0, 1), cA + hstep, voffA);
        if (wr == 1) PG8_BAR;
        PG8_WAIT_V(4); PG8_BAR;
        PG8_STAGE(PG8_SB(1, 0), cB + kstep, voffB); PG8_STAGE(PG8_SA(1, 0), cA + kstep, voffA); PG8_STAGE(PG8_SB(1, 1), cB + hstep + kstep, voffB);
        PG8_WAIT_V(6); PG8_BAR;
    }
    for (;;) {
        const bool has_next = S.next(ui + 1, nxt);
        const char* nA = has_next ? PG8_BASEA(nxt) : cA; const char* nB = has_next ? PG8_BASEB(nxt) : cB;
        for (int t = 0; t < nt; t += 2) {
            const bool last = (t == nt - 2);
            const char* a1 = cA + (size_t)(t + 1) * kstep;
            const char* a2 = last ? nA : cA + (size_t)(t + 2) * kstep; const char* b2 = last ? nB : cB + (size_t)(t + 2) * kstep;
            const char* a3 = a2 + kstep; const char* b3 = b2 + kstep;
            if (last && has_next) S.a_ready(nxt);
            if constexpr (SP2) {
            PG8_LDB(B0, 0, 0); PG8_LDB(B1, 0, 1); PG8_SCHED; PG8_LDA(At, 0, 0); PG8_STAGE(PG8_SA(1, 1), a1 + hstep, voffA);
            PG8_WAIT_V(8); PG8_WAIT_L(0); PG8_BAR; PG8_MMA(0, 0, At, B0); PG8_MMA(0, 1, At, B1); PG8_BAR; PG8_SCHED;
            PG8_LDA(At, 0, 1); PG8_STAGE(PG8_SB(0, 0), b2, voffB); PG8_STAGE(PG8_SB(0, 1), b2 + hstep, voffB); PG8_STAGE(PG8_SA(0, 0), a2, voffA);
            PG8_WAIT_V(8); PG8_WAIT_L(0); PG8_BAR; PG8_MMA(1, 0, At, B0); PG8_MMA(1, 1, At, B1); PG8_BAR; PG8_SCHED;
            PG8_LDB(B0, 1, 0); PG8_LDB(B1, 1, 1); PG8_SCHED; PG8_LDA(At, 1, 0); PG8_STAGE(PG8_SA(0, 1), a2 + hstep, voffA);
            PG8_WAIT_V(8); PG8_WAIT_L(0); PG8_BAR; PG8_MMA(0, 0, At, B0); PG8_MMA(0, 1, At, B1); PG8_BAR; PG8_SCHED;
            PG8_LDA(At, 1, 1); PG8_STAGE(PG8_SB(1, 0), b3, voffB); PG8_STAGE(PG8_SB(1, 1), b3 + hstep, voffB); PG8_STAGE(PG8_SA(1, 0), a3, voffA);
            PG8_WAIT_V(8); PG8_WAIT_L(0); PG8_BAR; PG8_MMA(1, 0, At, B0); PG8_MMA(1, 1, At, B1); PG8_BAR; PG8_SCHED;
            } else {
            PG8_LDB(B0, 0, 0); PG8_SCHED; PG8_LDA(At, 0, 0); PG8_STAGE(PG8_SA(1, 1), a1 + hstep, voffA);
            PG8_WAIT_L(8); PG8_BAR; PG8_WAIT_L(0); PG8_MMA(0, 0, At, B0); PG8_BAR; PG8_SCHED;
            PG8_LDB(B1, 0, 1); PG8_STAGE(PG8_SB(0, 0), b2, voffB);
            PG8_BAR; PG8_WAIT_L(0); PG8_MMA(0, 1, At, B1); PG8_BAR;
            PG8_LDA(At, 0, 1); PG8_STAGE(PG8_SA(0, 0), a2, voffA);
            PG8_BAR; PG8_WAIT_L(0); PG8_MMA(1, 0, At, B0); PG8_BAR; PG8_SCHED;
            PG8_STAGE(PG8_SB(0, 1), b2 + hstep, voffB);
            PG8_WAIT_V(6); PG8_BAR; PG8_MMA(1, 1, At, B1); PG8_BAR;
            PG8_LDB(B0, 1, 0); PG8_SCHED; PG8_LDA(At, 1, 0); PG8_STAGE(PG8_SA(0, 1), a2 + hstep, voffA);
            PG8_WAIT_L(8); PG8_BAR; PG8_WAIT_L(0); PG8_MMA(0, 0, At, B0); PG8_BAR; PG8_SCHED;
            PG8_LDB(B1, 1, 1); PG8_STAGE(PG8_SB(1, 0), b3, voffB);
            PG8_BAR; PG8_WAIT_L(0); PG8_MMA(0, 1, At, B1); PG8_BAR;
            PG8_LDA(At, 1, 1); PG8_STAGE(PG8_SA(1, 0), a3, voffA);
            PG8_BAR; PG8_WAIT_L(0); PG8_MMA(1, 0, At, B0); PG8_BAR; PG8_SCHED;
            PG8_STAGE(PG8_SB(1, 1), b3 + hstep, voffB);
            PG8_WAIT_V(6); PG8_BAR; PG8_MMA(1, 1, At, B1); PG8_BAR;
            }
        }
        if constexpr (ALIGN_EPI) { if (wr == 0) PG8_BAR; }
        if constexpr (!Epi::AFTER_DRAIN) { E(acc, cur, wr, wc, fr, fq); S.done(cur); }
        if (!has_next) break;
#pragma unroll
        for (int a = 0; a < 2; ++a)
#pragma unroll
            for (int b = 0; b < 2; ++b)
#pragma unroll
                for (int m = 0; m < 4; ++m)
#pragma unroll
                    for (int n = 0; n < 2; ++n) acc[a][b][m][n] = (f32x4){0.f, 0.f, 0.f, 0.f};
        cur = nxt; cA = nA; cB = nB; ++ui;
        if constexpr (ALIGN_EPI) { if (wr == 1) PG8_BAR; }
    }
    PG8_WAIT_V(0);
    if constexpr (!ALIGN_EPI) { if (wr == 0) PG8_BAR; }
    PG8_BAR;
    if constexpr (Epi::AFTER_DRAIN) { E.fused(acc, cur, wr, wc, fr, fq, lds, wid, lane); S.done(cur); }
#undef PG8_SW
#undef PG8_BASEA
#undef PG8_BASEB
#undef PG8_SA
#undef PG8_SB
#undef PG8_STAGE
#undef PG8_LDA
#undef PG8_LDB
#undef PG8_MMA
#undef PG8_WAIT_V
#undef PG8_WAIT_L
#undef PG8_BAR
#undef PG8_SCHED
}
}
constexpr int BATCH = 2, SEQ = 4096, DM = 2048, MTOK = BATCH * SEQ;
constexpr int NIN = 7680;
constexpr int FF = 5632, NCHUNK = 64;
constexpr int W_IN_LD = 7184;
constexpr float NORM_EPS = 1e-6f;
constexpr int NWAVES = 8;
constexpr size_t MiB = 1u << 20;
constexpr size_t WS_MODFIX = 0;
constexpr size_t CTL_ZERO_BYTES = 256 * 1024;
constexpr size_t WS_MODF = 512 * 1024;
constexpr size_t WS_WIN = 1 * MiB, WS_WOUT = 31 * MiB, WS_WFIN = 39 * MiB, WS_WFOUT = 83 * MiB;
constexpr size_t WS_H = 105 * MiB;
constexpr size_t WS_QT = 137 * MiB, WS_KT = 161 * MiB, WS_VT = 185 * MiB;
constexpr size_t WS_GT = 217 * MiB;
constexpr size_t WS_GG = 265 * MiB;
constexpr size_t WS_ST = 297 * MiB;
constexpr size_t WS_HID = 137 * MiB;
constexpr size_t WS_END = 361 * MiB;
constexpr int LDS_BYTES = 147456;

#define GAS __attribute__((address_space(1)))
#define LAS __attribute__((address_space(3)))
typedef unsigned short bf16;
typedef unsigned u32x4 __attribute__((ext_vector_type(4)));
typedef unsigned u32x2 __attribute__((ext_vector_type(2)));
typedef float f32x4 __attribute__((ext_vector_type(4)));
typedef short bf16x8 __attribute__((ext_vector_type(8)));
typedef short s16x4 __attribute__((ext_vector_type(4)));
#define LDS_WAIT() asm volatile("s_waitcnt lgkmcnt(0)" ::: "memory")
__device__ __forceinline__ unsigned pk2(float lo, float hi) { return pg8::cvt_pk_bf16(lo, hi); }
__device__ __forceinline__ float bf_lo(unsigned w) { return __uint_as_float(w << 16); }
__device__ __forceinline__ float bf_hi(unsigned w) { return __uint_as_float(w & 0xffff0000u); }
__device__ __forceinline__ float wave_sum(float v) {
#pragma unroll
    for (int o = 1; o < 64; o <<= 1) v += __shfl_xor(v, o);
    return v;
}

struct Frame {
    LAS unsigned char* lds;
    int tid, lane, wave, G;
    const float *x, *c, *w_ada, *b_ada, *norm_mix_w, *w_in, *w_gate, *b_gate, *gla_norm_w, *lbl, *hg_norm_w, *w_out, *norm_ffn_w, *w_ffn_in, *w_ffn_out, *final_w;
    float* out;
    long long* modfix; float* modf;
    bf16 *WinT, *WoutT, *WfinT, *WfoutT, *H, *QT, *KT, *VT, *GG, *ST, *HID;
    float* GT;
};

__device__ __forceinline__ void p0_transpose_item(const float* W, int ldw, int src0, int k0, bf16* WT, int K, int n0, LAS float* scr, int lane) {
    const int l15 = lane & 15, lq = lane >> 4;
#pragma unroll 4
    for (int i = 0; i < 16; ++i) { const int kk = 4 * i + lq; const f32x4 v = *(const f32x4*)(W + (size_t)(k0 + kk) * ldw + src0 + 4 * l15);
        LAS float* s = scr + kk * 65 + 4 * l15; s[0] = v[0]; s[1] = v[1]; s[2] = v[2]; s[3] = v[3]; }
    LDS_WAIT(); asm volatile("" ::: "memory");
    const int c = lane & 7;
#pragma unroll
    for (int j = 0; j < 8; ++j) { const int n = 8 * j + (lane >> 3); const LAS float* s = scr + (8 * c) * 65 + n;
        u32x4 o; o.x = pk2(s[0 * 65], s[1 * 65]); o.y = pk2(s[2 * 65], s[3 * 65]); o.z = pk2(s[4 * 65], s[5 * 65]); o.w = pk2(s[6 * 65], s[7 * 65]);
        *(u32x4*)(WT + (size_t)(n0 + n) * K + k0 + 8 * c) = o; }
    LDS_WAIT(); asm volatile("" ::: "memory");
}
__device__ __forceinline__ void p0_prologue(Frame& F) {
    LAS float* scr = (LAS float*)(F.lds) + F.wave * (64 * 65);
    const int gw = blockIdx.x * NWAVES + F.wave, NGW = F.G * NWAVES;
    constexpr int I_IN = 112 * 32, I_OUT = 32 * 32, I_FIN = 176 * 32, I_FOUT = 32 * 88, I_T = I_IN + I_OUT + I_FIN + I_FOUT, I_GEMV = 48 * 32;
    for (int it = gw; it < I_T + I_GEMV; it += NGW) {
        int r = it;
        if (r < I_IN) { const int kb = r / 112, nb = r % 112; const int n0 = nb < 48 ? 64 * nb : 3584 + 64 * (nb - 48); const int src0 = nb < 48 ? n0 : n0 - 496;
            p0_transpose_item(F.w_in, W_IN_LD, src0, 64 * kb, F.WinT, DM, n0, scr, F.lane); continue; } r -= I_IN;
        if (r < I_OUT) { const int kb = r / 32, nb = r % 32; p0_transpose_item(F.w_out, DM, 64 * nb, 64 * kb, F.WoutT, DM, 64 * nb, scr, F.lane); continue; } r -= I_OUT;
        if (r < I_FIN) { const int kb = r / 176, nb = r % 176; const int n0 = 64 * nb, t = n0 >> 8, w = n0 & 255; const int src0 = w < 128 ? 128 * t + w : FF + 128 * t + (w - 128);
            p0_transpose_item(F.w_ffn_in, 2 * FF, src0, 64 * kb, F.WfinT, DM, n0, scr, F.lane); continue; } r -= I_FIN;
        if (r < I_FOUT) { const int kb = r / 32, nb = r % 32; p0_transpose_item(F.w_ffn_out, DM, 64 * nb, 64 * kb, F.WfoutT, FF, 64 * nb, scr, F.lane); continue; } r -= I_FOUT;
        { const int cb = r % 48, ks = r / 48, k0 = 64 * ks, col = 256 * cb + 4 * F.lane;
          f32x4 a0 = {0.f, 0.f, 0.f, 0.f}, a1 = {0.f, 0.f, 0.f, 0.f};
#pragma unroll 8
          for (int kk = 0; kk < 64; ++kk) { const f32x4 w = *(const f32x4*)(F.w_ada + (size_t)(k0 + kk) * 12288 + col);
              const float c0 = F.c[k0 + kk], c1 = F.c[DM + k0 + kk]; const float s0 = c0 / (1.0f + __expf(-c0)), s1 = c1 / (1.0f + __expf(-c1));
              a0 += w * s0; a1 += w * s1; }
          if (ks == 0) { const f32x4 bv = *(const f32x4*)(F.b_ada + col); a0 += bv; a1 += bv; }
#pragma unroll
          for (int e = 0; e < 4; ++e) {
              atomicAdd((unsigned long long*)(F.modfix + col + e), (unsigned long long)__float2ll_rn(a0[e] * 4294967296.0f));
              atomicAdd((unsigned long long*)(F.modfix + 12288 + col + e), (unsigned long long)__float2ll_rn(a1[e] * 4294967296.0f)); }
        }
    }
    for (int id = blockIdx.x * 512 + F.tid; id < 512 * 256; id += F.G * 512) { const int n = id & 511, k8 = id >> 9;
        float wg[16];
#pragma unroll
        for (int r = 0; r < 16; ++r) wg[r] = F.w_gate[r * 512 + n];
        float o[8];
#pragma unroll
        for (int i = 0; i < 8; ++i) { const float* wr_ = F.w_in + (size_t)(8 * k8 + i) * W_IN_LD + 3072; float s = 0.f;
#pragma unroll
            for (int q = 0; q < 4; ++q) { const f32x4 v = *(const f32x4*)(wr_ + 4 * q); s += v[0] * wg[4 * q] + v[1] * wg[4 * q + 1] + v[2] * wg[4 * q + 2] + v[3] * wg[4 * q + 3]; }
            o[i] = s; }
        u32x4 w; w.x = pk2(o[0], o[1]); w.y = pk2(o[2], o[3]); w.z = pk2(o[4], o[5]); w.w = pk2(o[6], o[7]);
        *(u32x4*)(F.WinT + (size_t)(3072 + n) * DM + 8 * k8) = w; }
}
__device__ __forceinline__ float modfix_get(const long long* p) { return (float)(*p) * 2.3283064365386963e-10f; }

template <bool FROM_FIX>
__device__ __forceinline__ void norm_mod_rows(Frame& F, const float* X, const float* nw, int shift_off, int scale_off, bf16* O) {
    const int gw = blockIdx.x * NWAVES + F.wave, NGW = F.G * NWAVES;
    for (int m = gw; m < MTOK; m += NGW) { const int b = m >> 12;
        const f32x4* xr = (const f32x4*)(X + (size_t)m * DM) + F.lane;
        f32x4 v[8]; float ss = 0.f;
#pragma unroll
        for (int j = 0; j < 8; ++j) { v[j] = xr[64 * j]; ss += (v[j][0] * v[j][0] + v[j][1] * v[j][1]) + (v[j][2] * v[j][2] + v[j][3] * v[j][3]); }
        const float rinv = rsqrtf(wave_sum(ss) * (1.0f / DM) + NORM_EPS);
        u32x2* o8 = (u32x2*)(O + (size_t)m * DM) + F.lane;
#pragma unroll
        for (int j = 0; j < 8; ++j) { const int col = 256 * j + 4 * F.lane; const f32x4 w = *(const f32x4*)(nw + col); f32x4 sc, sh;
            if (FROM_FIX) { const long long* ps = F.modfix + b * 12288 + scale_off + col; const long long* ph = F.modfix + b * 12288 + shift_off + col;
#pragma unroll
                for (int e = 0; e < 4; ++e) { sc[e] = modfix_get(ps + e); sh[e] = modfix_get(ph + e); } }
            else { sc = *(const f32x4*)(F.modf + b * 12288 + scale_off + col); sh = *(const f32x4*)(F.modf + b * 12288 + shift_off + col); }
            const f32x4 y = (v[j] * rinv) * w * (sc + 1.0f) + sh;
            u32x2 p; p.x = pk2(y[0], y[1]); p.y = pk2(y[2], y[3]); o8[64 * j] = p; }
    }
}
__device__ __forceinline__ void final_norm_rows(Frame& F) {
    const int gw = blockIdx.x * NWAVES + F.wave, NGW = F.G * NWAVES;
    for (int m = gw; m < MTOK; m += NGW) {
        f32x4* xr = (f32x4*)(F.out + (size_t)m * DM) + F.lane;
        f32x4 v[8]; float ss = 0.f;
#pragma unroll
        for (int j = 0; j < 8; ++j) { v[j] = xr[64 * j]; ss += (v[j][0] * v[j][0] + v[j][1] * v[j][1]) + (v[j][2] * v[j][2] + v[j][3] * v[j][3]); }
        const float rinv = rsqrtf(wave_sum(ss) * (1.0f / DM) + NORM_EPS);
#pragma unroll
        for (int j = 0; j < 8; ++j) { const f32x4 w = *(const f32x4*)(F.final_w + 256 * j + 4 * F.lane); xr[64 * j] = (v[j] * rinv) * w; }
    }
}
struct S1Loads { bf16x8 k[2]; f32x4 g[2][2]; bf16x8 v[2]; };
__device__ __forceinline__ void s1_load(S1Loads& L, const bf16* kp, const float* gp, const bf16* vp) {
#pragma unroll
    for (int s = 0; s < 2; ++s) { L.k[s] = *(const bf16x8*)(kp + 32 * s); L.g[s][0] = *(const f32x4*)(gp + 32 * s); L.g[s][1] = *(const f32x4*)(gp + 32 * s + 4); L.v[s] = *(const bf16x8*)(vp + 32 * s); }
}
__device__ __forceinline__ void s1_phase(Frame& F) {
    const int lane = F.lane, c = lane & 15, g = lane >> 4;
    for (int u = blockIdx.x; u < 256; u += F.G) {
        int b, krow0, vrow0, dkb;
        if (u < 128) { const int half = u & 1, h = (u >> 4) & 3; dkb = (u >> 1) & 7; b = u >> 6; krow0 = 128 * h + 16 * dkb; vrow0 = 256 * h + 128 * half + 16 * F.wave; }
        else { const int v = u - 128, h = (v >> 3) & 7; dkb = v & 7; b = v >> 6; krow0 = 512 + 128 * h + 16 * dkb; vrow0 = 1024 + 128 * h + 16 * F.wave; }
        const bf16* kp = F.KT + (size_t)(krow0 + c) * MTOK + b * SEQ + 8 * g;
        const float* gp = F.GT + (size_t)(krow0 + c) * MTOK + b * SEQ + 8 * g;
        const bf16* vp = F.VT + (size_t)(vrow0 + c) * MTOK + b * SEQ + 8 * g;
        bf16* sp = F.ST + ((size_t)(b * NCHUNK) * 2048 + vrow0 + c) * 128 + 16 * dkb + 4 * g;
        f32x4 S = {0.f, 0.f, 0.f, 0.f};
        S1Loads cur, nxt;
        s1_load(cur, kp, gp, vp);
        for (int n = 0; n < NCHUNK; ++n) {
            const int nn = n < NCHUNK - 1 ? n + 1 : n;
            s1_load(nxt, kp + 64 * nn, gp + 64 * nn, vp + 64 * nn);
            { u32x2 w; w.x = pk2(S[0], S[1]); w.y = pk2(S[2], S[3]); *(u32x2*)(sp + (size_t)n * (2048 * 128)) = w; }
            float p[2][8];
#pragma unroll
            for (int s = 0; s < 2; ++s) { float a = 0.f;
#pragma unroll
                for (int t = 0; t < 8; ++t) { a += cur.g[s][t >> 2][t & 3]; p[s][t] = a; } }
            float t0[4], t1[4];
#pragma unroll
            for (int q = 0; q < 4; ++q) { t0[q] = __shfl(p[0][7], 16 * q + c); t1[q] = __shfl(p[1][7], 16 * q + c); }
            const float sum0 = (t0[0] + t0[1]) + (t0[2] + t0[3]);
            const float off0 = (g > 0 ? t0[0] : 0.f) + (g > 1 ? t0[1] : 0.f) + (g > 2 ? t0[2] : 0.f);
            const float off1 = sum0 + (g > 0 ? t1[0] : 0.f) + (g > 1 ? t1[1] : 0.f) + (g > 2 ? t1[2] : 0.f);
            const float blast = sum0 + (t1[0] + t1[1]) + (t1[2] + t1[3]);
            bf16x8 a[2];
#pragma unroll
            for (int s = 0; s < 2; ++s) { const float off = s == 0 ? off0 : off1; unsigned w[4]; const u32x4 kw4 = __builtin_bit_cast(u32x4, cur.k[s]);
#pragma unroll
                for (int t = 0; t < 8; t += 2) { const unsigned kw = kw4[t >> 1];
                    const float k0 = bf_lo(kw) * __expf(blast - (p[s][t] + off)), k1 = bf_hi(kw) * __expf(blast - (p[s][t + 1] + off));
                    w[t >> 1] = pk2(k0, k1); }
                u32x4 ww = {w[0], w[1], w[2], w[3]}; a[s] = __builtin_bit_cast(bf16x8, ww); }
            const float eb = __expf(blast);
#pragma unroll
            for (int r = 0; r < 4; ++r) S[r] *= __shfl(eb, 4 * g + r);
            S = __builtin_amdgcn_mfma_f32_16x16x32_bf16(a[0], cur.v[0], S, 0, 0, 0);
            S = __builtin_amdgcn_mfma_f32_16x16x32_bf16(a[1], cur.v[1], S, 0, 0, 0);
            cur = nxt;
        }
    }
}

__device__ __forceinline__ s16x4 tr16(LAS const unsigned char* p) { typedef short v4i16_t __attribute__((ext_vector_type(4))); return __builtin_bit_cast(s16x4, __builtin_amdgcn_ds_read_tr16_b64_v4i16((LAS v4i16_t*)p)); }
__device__ __forceinline__ void s2_phase(Frame& F) {
    constexpr int IST = 144;
    LAS unsigned char* QI = F.lds; LAS unsigned char* KI = F.lds + 128 * IST; LAS float* red = (LAS float*)(F.lds + 2 * 128 * IST);
    const int tid = F.tid, lane = F.lane, wave = F.wave, c = lane & 15, g = lane >> 4, it = wave & 3, eh = wave >> 2;
    for (int u = blockIdx.x; u < 12 * 128; u += F.G) {
        const int hh = u >> 7, b = (u >> 6) & 1, n = u & 63;
        const bool gla = hh < 4;
        const int qrow0 = 128 * hh, vrow0 = gla ? 256 * hh : 1024 + 128 * (hh - 4), dv = gla ? 256 : 128, net = gla ? 8 : 4;
        const int tok0 = b * SEQ + 64 * n;
        {
            const int d = tid >> 2, tg = tid & 3; const size_t off = (size_t)(qrow0 + d) * MTOK + tok0 + 16 * tg;
            const u32x4 q0 = *(const u32x4*)(F.QT + off), q1 = *(const u32x4*)(F.QT + off + 8), k0 = *(const u32x4*)(F.KT + off), k1 = *(const u32x4*)(F.KT + off + 8);
            f32x4 gv[4];
#pragma unroll
            for (int i = 0; i < 4; ++i) gv[i] = *(const f32x4*)(F.GT + off + 4 * i);
            float p[16]; float a = 0.f;
#pragma unroll
            for (int i = 0; i < 16; ++i) { a += gv[i >> 2][i & 3]; p[i] = a; }
            const float s1 = __shfl_up(a, 1), s2 = __shfl_up(a, 2), s3 = __shfl_up(a, 3);
            const float offb = (tg > 0 ? s1 : 0.f) + (tg > 1 ? s2 : 0.f) + (tg > 2 ? s3 : 0.f);
            unsigned qo[8], ko[8];
#pragma unroll
            for (int i = 0; i < 8; ++i) { const unsigned qw = i < 4 ? q0[i] : q1[i - 4], kw = i < 4 ? k0[i] : k1[i - 4];
                const float b0 = p[2 * i] + offb, b1 = p[2 * i + 1] + offb;
                qo[i] = pk2(bf_lo(qw) * __expf(b0), bf_hi(qw) * __expf(b1)); ko[i] = pk2(bf_lo(kw) * __expf(-b0), bf_hi(kw) * __expf(-b1)); }
            LAS u32x4* qd = (LAS u32x4*)(QI + d * IST + 32 * tg); LAS u32x4* kd = (LAS u32x4*)(KI + d * IST + 32 * tg);
            qd[0] = (u32x4){qo[0], qo[1], qo[2], qo[3]}; qd[1] = (u32x4){qo[4], qo[5], qo[6], qo[7]};
            kd[0] = (u32x4){ko[0], ko[1], ko[2], ko[3]}; kd[1] = (u32x4){ko[4], ko[5], ko[6], ko[7]};
        }
        __syncthreads();
        const int tq = c >> 2, tp = c & 3;
        bf16x8 qf[4];
#pragma unroll
        for (int s = 0; s < 4; ++s) { const s16x4 lo = tr16(QI + (32 * s + 8 * g + tq) * IST + 32 * it + 8 * tp), hi = tr16(QI + (32 * s + 8 * g + 4 + tq) * IST + 32 * it + 8 * tp);
            qf[s] = __builtin_shufflevector(lo, hi, 0, 1, 2, 3, 4, 5, 6, 7); }
        f32x4 sT[4];
#pragma unroll
        for (int jt = 0; jt < 4; ++jt) { f32x4 acc = {0.f, 0.f, 0.f, 0.f};
#pragma unroll
            for (int s = 0; s < 4; ++s) { const s16x4 lo = tr16(KI + (32 * s + 8 * g + tq) * IST + 32 * jt + 8 * tp), hi = tr16(KI + (32 * s + 8 * g + 4 + tq) * IST + 32 * jt + 8 * tp);
                const bf16x8 kf = __builtin_shufflevector(lo, hi, 0, 1, 2, 3, 4, 5, 6, 7);
                acc = __builtin_amdgcn_mfma_f32_16x16x32_bf16(kf, qf[s], acc, 0, 0, 0); }
#pragma unroll
            for (int r = 0; r < 4; ++r) { const bool keep = (jt < it) || (jt == it && 4 * g + r <= c); acc[r] = keep ? acc[r] : 0.f; }
            sT[jt] = acc; }
        bf16x8 pb[2];
#pragma unroll
        for (int s = 0; s < 2; ++s) { u32x4 w; w.x = pk2(sT[2 * s][0], sT[2 * s][1]); w.y = pk2(sT[2 * s][2], sT[2 * s][3]); w.z = pk2(sT[2 * s + 1][0], sT[2 * s + 1][1]); w.w = pk2(sT[2 * s + 1][2], sT[2 * s + 1][3]);
            pb[s] = __builtin_bit_cast(bf16x8, w); }
        f32x4 o[8]; float ss = 0.f;
        const int ebase = eh * (dv >> 1);
#pragma unroll
        for (int et = 0; et < 8; ++et) { o[et] = (f32x4){0.f, 0.f, 0.f, 0.f};
            if (et < net) { const int erow = vrow0 + ebase + 16 * et + c;
                const bf16* stp = F.ST + ((size_t)(b * NCHUNK + n) * 2048 + erow) * 128 + 8 * g;
                const bf16* vtp = F.VT + (size_t)erow * MTOK + tok0 + 4 * g;
                f32x4 acc = {0.f, 0.f, 0.f, 0.f};
#pragma unroll
                for (int s = 0; s < 4; ++s) { const bf16x8 a = *(const bf16x8*)(stp + 32 * s); acc = __builtin_amdgcn_mfma_f32_16x16x32_bf16(a, qf[s], acc, 0, 0, 0); }
#pragma unroll
                for (int s = 0; s < 2; ++s) { const s16x4 lo = *(const s16x4*)(vtp + 32 * s), hi = *(const s16x4*)(vtp + 32 * s + 16);
                    const bf16x8 a = __builtin_shufflevector(lo, hi, 0, 1, 2, 3, 4, 5, 6, 7); acc = __builtin_amdgcn_mfma_f32_16x16x32_bf16(a, pb[s], acc, 0, 0, 0); }
                o[et] = acc; ss += (acc[0] * acc[0] + acc[1] * acc[1]) + (acc[2] * acc[2] + acc[3] * acc[3]); } }
        ss += __shfl_xor(ss, 16); ss += __shfl_xor(ss, 32);
        if (g == 0) red[wave * 16 + c] = ss;
        __syncthreads();
        const float tot = red[wave * 16 + c] + red[(wave ^ 4) * 16 + c];
        const float rinv = rsqrtf(tot / (float)dv + NORM_EPS);
        const float* nw = gla ? F.gla_norm_w : F.hg_norm_w;
        const size_t orow = (size_t)(tok0 + 16 * it + c) * DM + vrow0 + ebase + 4 * g;
#pragma unroll
        for (int et = 0; et < 8; ++et) if (et < net) { const f32x4 w = *(const f32x4*)(nw + ebase + 16 * et + 4 * g); const u32x2 gg = *(const u32x2*)(F.GG + orow + 16 * et);
            const f32x4 y = o[et] * rinv * w; u32x2 p; p.x = pk2(y[0] * bf_lo(gg.x), y[1] * bf_hi(gg.x)); p.y = pk2(y[2] * bf_lo(gg.y), y[3] * bf_hi(gg.y));
            *(u32x2*)(F.H + orow + 16 * et) = p; }
    }
}
struct Args { const float* in[16]; float* out; unsigned char* ws; };
__global__ void __launch_bounds__(NWAVES * 64, 2) fwd_megakernel(Args args) {
    extern __shared__ __attribute__((aligned(16))) unsigned char lds_raw[];
    cg::grid_group grid = cg::this_grid();
    Frame F;
    F.lds = (LAS unsigned char*)lds_raw;
    F.tid = threadIdx.x; F.lane = F.tid & 63; F.wave = __builtin_amdgcn_readfirstlane(F.tid >> 6); F.G = gridDim.x;
    F.x = args.in[0]; F.c = args.in[1]; F.w_ada = args.in[2]; F.b_ada = args.in[3]; F.norm_mix_w = args.in[4]; F.w_in = args.in[5]; F.w_gate = args.in[6]; F.b_gate = args.in[7];
    F.gla_norm_w = args.in[8]; F.lbl = args.in[9]; F.hg_norm_w = args.in[10]; F.w_out = args.in[11]; F.norm_ffn_w = args.in[12]; F.w_ffn_in = args.in[13]; F.w_ffn_out = args.in[14]; F.final_w = args.in[15];
    F.out = args.out;
    unsigned char* ws = args.ws;
    F.modfix = (long long*)(ws + WS_MODFIX); F.modf = (float*)(ws + WS_MODF);
    F.WinT = (bf16*)(ws + WS_WIN); F.WoutT = (bf16*)(ws + WS_WOUT); F.WfinT = (bf16*)(ws + WS_WFIN); F.WfoutT = (bf16*)(ws + WS_WFOUT);
    F.H = (bf16*)(ws + WS_H); F.QT = (bf16*)(ws + WS_QT); F.KT = (bf16*)(ws + WS_KT); F.VT = (bf16*)(ws + WS_VT); F.GT = (float*)(ws + WS_GT);
    F.GG = (bf16*)(ws + WS_GG); F.ST = (bf16*)(ws + WS_ST); F.HID = (bf16*)(ws + WS_HID);

    p0_prologue(F);
    grid.sync();
    for (int id = blockIdx.x * 512 + F.tid; id < 2 * 12288; id += F.G * 512) F.modf[id] = modfix_get(F.modfix + id);
    norm_mod_rows<true>(F, F.x, F.norm_mix_w, 0, 2048, F.H);
    grid.sync();
    {   pg8::Gemm g{F.H, F.WinT, MTOK, NIN, DM, 0x03FFF0FFu}; pg8::StaticOrder S; S.init(MTOK, NIN, F.G, (int)blockIdx.x);
        pg8::EpiInProj E{F.QT, F.KT, F.VT, F.GT, F.GG, F.b_gate, F.lbl};
        pg8::gemm_phase<pg8::EpiInProj, pg8::StaticOrder, true, true>(F.lds, g, S, E); }
    grid.sync();
    s1_phase(F);
    grid.sync();
    s2_phase(F);
    grid.sync();
    {   pg8::Gemm g{F.H, F.WoutT, MTOK, DM, DM, 0u}; pg8::StaticOrder S; S.init(MTOK, DM, F.G, (int)blockIdx.x);
        pg8::EpiResid E{F.x, F.out, F.modf + 4096};
        pg8::gemm_phase<pg8::EpiResid, pg8::StaticOrder, true, true>(F.lds, g, S, E); }
    grid.sync();
    norm_mod_rows<false>(F, F.out, F.norm_ffn_w, 6144, 8192, F.H);
    grid.sync();
    {   pg8::Gemm g{F.H, F.WfinT, MTOK, 2 * FF, DM, 0u}; pg8::StaticOrder S; S.init(MTOK, 2 * FF, F.G, (int)blockIdx.x);
        pg8::EpiSwiGLU E{F.HID, FF};
        pg8::gemm_phase<pg8::EpiSwiGLU, pg8::StaticOrder, true, true>(F.lds, g, S, E); }
    grid.sync();
    {   pg8::Gemm g{F.HID, F.WfoutT, MTOK, DM, FF, 0u}; pg8::StaticOrder S; S.init(MTOK, DM, F.G, (int)blockIdx.x);
        pg8::EpiResid E{F.out, F.out, F.modf + 10240};
        pg8::gemm_phase<pg8::EpiResid, pg8::StaticOrder, true, true>(F.lds, g, S, E); }
    grid.sync();
    final_norm_rows(F);
}

extern "C" void kernel_launch(void* const* d_in, const int* in_sizes, int n_in, void* d_out, int out_size, void* d_ws, size_t ws_size, hipStream_t stream) {
    static int grid = 0;
    if (grid == 0) {
        if (n_in != 16 || out_size != MTOK * DM || ws_size < WS_END) { fprintf(stderr, "kernel_launch: unexpected shapes (n_in %d out %d ws %zu)\n", n_in, out_size, ws_size); grid = -1; return; }
        int dev = 0, cus = 0, per_cu = 0;
        (void)hipGetDevice(&dev); (void)hipDeviceGetAttribute(&cus, hipDeviceAttributeMultiprocessorCount, dev);
        (void)hipFuncSetAttribute((const void*)fwd_megakernel, hipFuncAttributeMaxDynamicSharedMemorySize, LDS_BYTES);
        if (hipOccupancyMaxActiveBlocksPerMultiprocessor(&per_cu, (const void*)fwd_megakernel, NWAVES * 64, LDS_BYTES) != hipSuccess || per_cu < 1) per_cu = 1;
        (void)hipGetLastError();
        if (cus <= 0) cus = 256;
        grid = cus * per_cu; if (grid > 256) grid = 256;
    }
    if (grid < 0) return;
    (void)hipMemsetAsync((char*)d_ws + WS_MODFIX, 0, CTL_ZERO_BYTES, stream);
    Args a{};
    for (int i = 0; i < 16; ++i) a.in[i] = (const float*)d_in[i];
    a.out = (float*)d_out; a.ws = (unsigned char*)d_ws;
    void* kargs[] = {&a};
    hipError_t e = hipLaunchCooperativeKernel((const void*)fwd_megakernel, dim3(grid), dim3(NWAVES * 64), kargs, LDS_BYTES, stream);
    if (e != hipSuccess) fprintf(stderr, "cooperative launch failed: %s (grid %d)\n", hipGetErrorString(e), grid);
}
```

```cpp
#include <hip/hip_runtime.h>
#include <hip/hip_cooperative_groups.h>
#include <cstdio>
#include <cstdint>
namespace cg = cooperative_groups;
namespace pg8 {
#define PG8_LAS __attribute__((address_space(3)))
typedef unsigned short bf16_t;
typedef short bf16x8 __attribute__((ext_vector_type(8)));
typedef float f32x4 __attribute__((ext_vector_type(4)));
typedef unsigned u32x4 __attribute__((ext_vector_type(4)));
constexpr int BM = 256, BK = 64, HALF = 128, HTB = HALF * BK * 2  , STAGE_BYTES = 8 * HTB, NXCD = 8, WGM = 8;

__host__ __device__ __forceinline__ int lds_byte(int r, int c) { const int st = (r >> 4) * 2 + (c >> 5), rr = r & 15, cc = c & 31, ob = rr * 64 + cc * 2; return st * 1024 + (ob ^ (((ob >> 9) & 1) << 5)); }
__host__ __device__ __forceinline__ void stage_rc(int b, int& R, int& C) { const int st = b / 1024, sb = b % 1024, swz = sb ^ (((sb >> 9) & 1) << 5); R = (st >> 1) * 16 + swz / 64; C = (st & 1) * 32 + (swz % 64) / 2; }
__host__ __device__ __forceinline__ int perm32(int rho) { const int n = rho >> 4, i = rho & 15; return 8 * (i >> 2) + 4 * n + (i & 3); }

struct Unit { int pm, pn; };
struct Gemm { const bf16_t* A; const bf16_t* Bt; int M, N, K; unsigned swap; };

struct StaticOrder {
    int nM, nN, nwg, G, c;
    __host__ __device__ void init(int M, int N, int G_, int c_) { nM = M / BM; nN = N / BM; nwg = nM * nN; G = G_; c = c_; }
    __host__ __device__ bool next(int i, Unit& u) const {
        const long L = (long)i * G + c; if (L >= nwg) return false;
        int wgid = (int)L; { const int q = nwg / NXCD, r = nwg % NXCD, xcd = wgid % NXCD, off = wgid / NXCD; wgid = (xcd < r ? xcd * (q + 1) : r * (q + 1) + (xcd - r) * q) + off; }
        const int nig = WGM * nN, gid = wgid / nig, fm = gid * WGM, gsz = (nM - fm) < WGM ? (nM - fm) : WGM;
        u.pm = fm + ((wgid % nig) % gsz); u.pn = (wgid % nig) / gsz; return true;
    }
    __device__ __forceinline__ void a_ready(const Unit&) const {}
    __device__ __forceinline__ void done(const Unit&) const {}
};

typedef float f32x2_t __attribute__((ext_vector_type(2))); typedef __bf16 bf16x2_t __attribute__((ext_vector_type(2)));
__device__ __forceinline__ unsigned cvt_pk_bf16(float lo, float hi) { f32x2_t v = {lo, hi}; bf16x2_t b = __builtin_convertvector(v, bf16x2_t); return __builtin_bit_cast(unsigned, b); }
typedef float f32x2 __attribute__((ext_vector_type(2)));
__device__ __forceinline__ float silu_f(float x) { return x / (1.0f + __expf(-x)); }
__device__ __forceinline__ float logsig_f(float x) { return fminf(x, 0.f) - __logf(1.0f + __expf(-fabsf(x))); }

constexpr int MTOK_ = 8192;
struct EpiInProj {
    static constexpr bool PERM = true, AFTER_DRAIN = false;
    bf16_t* QT; bf16_t* KT; bf16_t* VT; float* GT; bf16_t* GG; const float* bgate; const float* lbl;
    __device__ __forceinline__ void operator()(const f32x4 (&acc)[2][2][4][2], const Unit& u, int wr, int wc, int fr, int fq) const {
        const int pn = u.pn;
        int type; bf16_t* dst; int rowoff; float scale = 1.0f;
        if (pn < 2)       { type = 0; dst = QT; rowoff = 256 * pn; scale = 0.08838834764831845f; }
        else if (pn < 4)  { type = 0; dst = KT; rowoff = 256 * (pn - 2); }
        else if (pn < 8)  { type = 0; dst = VT; rowoff = 256 * (pn - 4); }
        else if (pn < 12) { type = 4; dst = GG; rowoff = 256 * (pn - 8); }
        else if (pn < 14) { type = 2; dst = nullptr; rowoff = 256 * (pn - 12); }
        else if (pn < 18) { type = 1; dst = QT; rowoff = 512 + 256 * (pn - 14); }
        else if (pn < 22) { type = 3; dst = KT; rowoff = 512 + 256 * (pn - 18); }
        else if (pn < 26) { type = 0; dst = VT; rowoff = 1024 + 256 * (pn - 22); }
        else              { type = 4; dst = GG; rowoff = 1024 + 256 * (pn - 26); }
        if (type == 4) {
            const int row0 = u.pm * BM + wr * 64 + fr, col0 = rowoff + wc * 32 + 8 * fq;
#pragma unroll
            for (int ai = 0; ai < 2; ++ai)
#pragma unroll
                for (int m = 0; m < 4; ++m) { bf16_t* rowp = GG + (size_t)(row0 + ai * HALF + m * 16) * 2048 + col0;
#pragma unroll
                    for (int bj = 0; bj < 2; ++bj) { const f32x4 v0 = acc[ai][bj][m][0], v1 = acc[ai][bj][m][1]; u32x4 w;
                        w.x = cvt_pk_bf16(silu_f(v0[0]), silu_f(v0[1])); w.y = cvt_pk_bf16(silu_f(v0[2]), silu_f(v0[3]));
                        w.z = cvt_pk_bf16(silu_f(v1[0]), silu_f(v1[1])); w.w = cvt_pk_bf16(silu_f(v1[2]), silu_f(v1[3]));
                        *(u32x4*)(rowp + bj * HALF) = w; } }
            return;
        }
        const int rl0 = wr * 64 + fr;
        const int col0 = u.pm * BM + wc * 32 + 8 * fq;
        if (type == 0 || type == 1) {
#pragma unroll
            for (int ai = 0; ai < 2; ++ai)
#pragma unroll
                for (int m = 0; m < 4; ++m) { bf16_t* rowp = dst + (size_t)(rowoff + rl0 + ai * HALF + m * 16) * MTOK_ + col0;
#pragma unroll
                    for (int bj = 0; bj < 2; ++bj) { f32x4 v0 = acc[ai][bj][m][0], v1 = acc[ai][bj][m][1]; u32x4 w;
                        if (type == 1) { v0 = (f32x4){silu_f(v0[0]), silu_f(v0[1]), silu_f(v0[2]), silu_f(v0[3])}; v1 = (f32x4){silu_f(v1[0]), silu_f(v1[1]), silu_f(v1[2]), silu_f(v1[3])}; }
                        else { v0 = v0 * scale; v1 = v1 * scale; }
                        w.x = cvt_pk_bf16(v0[0], v0[1]); w.y = cvt_pk_bf16(v0[2], v0[3]); w.z = cvt_pk_bf16(v1[0], v1[1]); w.w = cvt_pk_bf16(v1[2], v1[3]);
                        *(u32x4*)(rowp + bj * HALF) = w; } }
            return;
        }
        if (type == 2) {
#pragma unroll
            for (int ai = 0; ai < 2; ++ai)
#pragma unroll
                for (int m = 0; m < 4; ++m) { const int row = rowoff + rl0 + ai * HALF + m * 16; const float bias = bgate[row]; float* rowp = GT + (size_t)row * MTOK_ + col0;
#pragma unroll
                    for (int bj = 0; bj < 2; ++bj) { const f32x4 v0 = acc[ai][bj][m][0], v1 = acc[ai][bj][m][1];
                        *(f32x4*)(rowp + bj * HALF) = (f32x4){logsig_f(v0[0] + bias), logsig_f(v0[1] + bias), logsig_f(v0[2] + bias), logsig_f(v0[3] + bias)} * 0.0625f;
                        *(f32x4*)(rowp + bj * HALF + 4) = (f32x4){logsig_f(v1[0] + bias), logsig_f(v1[1] + bias), logsig_f(v1[2] + bias), logsig_f(v1[3] + bias)} * 0.0625f; } }
            return;
        }
#pragma unroll
        for (int ai = 0; ai < 2; ++ai)
#pragma unroll
            for (int m = 0; m < 4; ++m) { const int row = rowoff + rl0 + ai * HALF + m * 16; const int li = row - 512;
                const float lb = 1.0f / (1.0f + __expf(lbl[1024 + li] - lbl[li])), omlb = 1.0f - lb;
                bf16_t* krow = KT + (size_t)row * MTOK_ + col0; float* grow = GT + (size_t)row * MTOK_ + col0;
#pragma unroll
                for (int bj = 0; bj < 2; ++bj) { float kv[8], gv[8];
#pragma unroll
                    for (int n = 0; n < 2; ++n)
#pragma unroll
                        for (int e = 0; e < 4; ++e) { const float x = acc[ai][bj][m][n][e]; const float ex = __expf(-fabsf(x)); const float sp = 1.0f / (1.0f + ex);
                            const float sg = x >= 0.f ? sp : ex * sp, omsg = x >= 0.f ? ex * sp : sp;
                            kv[4 * n + e] = omlb * omsg; gv[4 * n + e] = __logf(lb + omlb * sg); }
                    u32x4 w; w.x = cvt_pk_bf16(kv[0], kv[1]); w.y = cvt_pk_bf16(kv[2], kv[3]); w.z = cvt_pk_bf16(kv[4], kv[5]); w.w = cvt_pk_bf16(kv[6], kv[7]);
                    *(u32x4*)(krow + bj * HALF) = w;
                    *(f32x4*)(grow + bj * HALF) = (f32x4){gv[0], gv[1], gv[2], gv[3]}; *(f32x4*)(grow + bj * HALF + 4) = (f32x4){gv[4], gv[5], gv[6], gv[7]}; } }
    }
};
struct EpiSwiGLU {
    static constexpr bool PERM = true, AFTER_DRAIN = false;
    bf16_t* O; int ldc;
    __device__ __forceinline__ void operator()(const f32x4 (&acc)[2][2][4][2], const Unit& u, int wr, int wc, int fr, int fq) const {
        const int row0 = u.pm * BM + wr * 64 + fr, col0 = u.pn * HALF + wc * 32 + 8 * fq;
#pragma unroll
        for (int ai = 0; ai < 2; ++ai)
#pragma unroll
            for (int m = 0; m < 4; ++m) { bf16_t* rowp = O + (size_t)(row0 + ai * HALF + m * 16) * ldc + col0;
                const f32x4 a0 = acc[ai][0][m][0], a1 = acc[ai][0][m][1], u0 = acc[ai][1][m][0], u1 = acc[ai][1][m][1]; u32x4 w;
                w.x = cvt_pk_bf16(silu_f(a0[0]) * u0[0], silu_f(a0[1]) * u0[1]); w.y = cvt_pk_bf16(silu_f(a0[2]) * u0[2], silu_f(a0[3]) * u0[3]);
                w.z = cvt_pk_bf16(silu_f(a1[0]) * u1[0], silu_f(a1[1]) * u1[1]); w.w = cvt_pk_bf16(silu_f(a1[2]) * u1[2], silu_f(a1[3]) * u1[3]);
                *(u32x4*)rowp = w; }
    }
};
struct EpiResid {
    static constexpr bool PERM = true, AFTER_DRAIN = false;
    const float* base; float* out; const float* gate;
    __device__ __forceinline__ void operator()(const f32x4 (&acc)[2][2][4][2], const Unit& u, int wr, int wc, int fr, int fq) const {
        const int row0 = u.pm * BM + wr * 64 + fr, col0 = u.pn * BM + wc * 32 + 8 * fq;
        const float* gp = gate + (size_t)(u.pm >> 4) * 12288 + col0;
        f32x4 gv[2][2];
#pragma unroll
        for (int bj = 0; bj < 2; ++bj)
#pragma unroll
            for (int n = 0; n < 2; ++n) gv[bj][n] = *(const f32x4*)(gp + bj * HALF + 4 * n);
#pragma unroll
        for (int ai = 0; ai < 2; ++ai)
#pragma unroll
            for (int m = 0; m < 4; ++m) { const size_t off = (size_t)(row0 + ai * HALF + m * 16) * 2048 + col0;
#pragma unroll
                for (int bj = 0; bj < 2; ++bj)
#pragma unroll
                    for (int n = 0; n < 2; ++n) { const f32x4 bs = *(const f32x4*)(base + off + bj * HALF + 4 * n);
                        *(f32x4*)(out + off + bj * HALF + 4 * n) = bs + gv[bj][n] * acc[ai][bj][m][n]; } }
    }
};
template <class Epi, class Sched, bool ALIGN_EPI = false, bool SP2 = false>
__device__ __forceinline__ void gemm_phase(PG8_LAS unsigned char* lds, const Gemm g, const Sched& S, const Epi& E) {
    const int tid = threadIdx.x, wid = __builtin_amdgcn_readfirstlane(tid >> 6), lane = tid & 63, wr = wid >> 2, wc = wid & 3, fr = lane & 15, fq = lane >> 4;
    const int K = g.K, nt = K / BK;
    unsigned voffA[2], voffB[2];
#pragma unroll
    for (int i = 0; i < 2; ++i) { int R, C; stage_rc(tid * 16 + i * 8192, R, C); const int Rb = Epi::PERM ? ((R & ~31) + perm32(R & 31)) : R;
        voffA[i] = (unsigned)(R * K + C) * 2u; voffB[i] = (unsigned)(Rb * K + C) * 2u; }
    const size_t kstep = (size_t)(BK * 2);
    const size_t hstep = (size_t)HALF * K * 2;
    const size_t tstep = 2 * hstep;
    const unsigned ldsw = (unsigned)wid * 1024u;
    const int aoff = lds_byte(wr * 64 + fr, fq * 8), boff = lds_byte(wc * 32 + fr, fq * 8);
#define PG8_SA(b, h) (((b) * 2 + (h)) * HTB)
#define PG8_SB(b, h) ((4 + (b) * 2 + (h)) * HTB)
#define PG8_STAGE(bufoff, gbase, voff) do { _Pragma("unroll") for (int _i = 0; _i < 2; ++_i) \
        __builtin_amdgcn_global_load_lds((const unsigned*)((const char*)(gbase) + (voff)[_i]), (PG8_LAS unsigned*)(lds + (bufoff) + ldsw + _i * 8192), 16, 0, 0); } while (0)
#define PG8_LDA(dst, b, h) do { _Pragma("unroll") for (int m = 0; m < 4; ++m) _Pragma("unroll") for (int k = 0; k < 2; ++k) dst[m][k] = *(const PG8_LAS bf16x8*)(lds + PG8_SA(b, h) + aoff + m * 2048 + k * 1024); } while (0)
#define PG8_LDB(dst, b, h) do { _Pragma("unroll") for (int n = 0; n < 2; ++n) _Pragma("unroll") for (int k = 0; k < 2; ++k) dst[n][k] = *(const PG8_LAS bf16x8*)(lds + PG8_SB(b, h) + boff + n * 2048 + k * 1024); } while (0)
#define PG8_MMA(ai, bj, At, Bt) do { __builtin_amdgcn_s_setprio(1); _Pragma("unroll") for (int m = 0; m < 4; ++m) _Pragma("unroll") for (int n = 0; n < 2; ++n) _Pragma("unroll") for (int k = 0; k < 2; ++k) \
        acc[ai][bj][m][n] = __builtin_amdgcn_mfma_f32_16x16x32_bf16(Bt[n][k], At[m][k], acc[ai][bj][m][n], 0, 0, 0); __builtin_amdgcn_s_setprio(0); } while (0)
#define PG8_WAIT_V(n) asm volatile("s_waitcnt vmcnt(" #n ")" ::: "memory")
#define PG8_WAIT_L(n) asm volatile("s_waitcnt lgkmcnt(" #n ")" ::: "memory")
#define PG8_BAR __builtin_amdgcn_s_barrier()
#define PG8_SCHED __builtin_amdgcn_sched_barrier(0)
    Unit cur, nxt; int ui = 0;
    if (!S.next(0, cur)) return;
    f32x4 acc[2][2][4][2];
#pragma unroll
    for (int a = 0; a < 2; ++a)
#pragma unroll
        for (int b = 0; b < 2; ++b)
#pragma unroll
            for (int m = 0; m < 4; ++m)
#pragma unroll
                for (int n = 0; n < 2; ++n) acc[a][b][m][n] = (f32x4){0.f, 0.f, 0.f, 0.f};
    bf16x8 At[4][2], B0[2][2], B1[2][2];
#define PG8_SW(u) (((u).pn < 32) && ((g.swap >> (u).pn) & 1u))
#define PG8_BASEA(u) (PG8_SW(u) ? (const char*)g.Bt + (size_t)(u).pn * tstep : (const char*)g.A + (size_t)(u).pm * tstep)
#define PG8_BASEB(u) (PG8_SW(u) ? (const char*)g.A + (size_t)(u).pm * tstep : (const char*)g.Bt + (size_t)(u).pn * tstep)
    const char* cA = PG8_BASEA(cur); const char* cB = PG8_BASEB(cur);
    S.a_ready(cur);
    if constexpr (SP2) {
        PG8_STAGE(PG8_SB(0, 0), cB, voffB); PG8_STAGE(PG8_SB(0, 1), cB + hstep, voffB); PG8_STAGE(PG8_SA(0, 0), cA, voffA); PG8_STAGE(PG8_SA(0, 1), cA + hstep, voffA);
        if (wr == 1) PG8_BAR;
        PG8_WAIT_V(2); PG8_BAR;
        PG8_STAGE(PG8_SB(1, 0), cB + kstep, voffB); PG8_STAGE(PG8_SA(1, 0), cA + kstep, voffA); PG8_STAGE(PG8_SB(1, 1), cB + hstep + kstep, voffB);
        PG8_WAIT_V(6); PG8_BAR;
    } else {
        PG8_STAGE(PG8_SB(0, 0), cB, voffB); PG8_STAGE(PG8_SA(0, 0), cA, voffA); PG8_STAGE(PG8_SB(0, 1), cB + hstep, voffB); PG8_STAGE(PG8_SA(0, 1), cA + hstep, voffA);
        if (wr == 1) PG8_BAR;
        PG8_WAIT_V(4); PG8_BAR;
        PG8_STAGE(PG8_SB(1, 0), cB + kstep, voffB); PG8_STAGE(PG8_SA(1, 0), cA + kstep, voffA); PG8_STAGE(PG8_SB(1, 1), cB + hstep + kstep, voffB);
        PG8_WAIT_V(6); PG8_BAR;
    }
    for (;;) {
        const bool has_next = S.next(ui + 1, nxt);
        const char* nA = has_next ? PG8_BASEA(nxt) : cA; const char* nB = has_next ? PG8_BASEB(nxt) : cB;
        for (int t = 0; t < nt; t += 2) {
            const bool last = (t == nt - 2);
            const char* a1 = cA + (size_t)(t + 1) * kstep;
            const char* a2 = last ? nA : cA + (size_t)(t + 2) * kstep; const char* b2 = last ? nB : cB + (size_t)(t + 2) * kstep;
            const char* a3 = a2 + kstep; const char* b3 = b2 + kstep;
            if (last && has_next) S.a_ready(nxt);
            if constexpr (SP2) {
            PG8_LDB(B0, 0, 0); PG8_LDB(B1, 0, 1); PG8_SCHED; PG8_LDA(At, 0, 0); PG8_STAGE(PG8_SA(1, 1), a1 + hstep, voffA);
            PG8_WAIT_V(8); PG8_WAIT_L(0); PG8_BAR; PG8_MMA(0, 0, At, B0); PG8_MMA(0, 1, At, B1); PG8_BAR; PG8_SCHED;
            PG8_LDA(At, 0, 1); PG8_STAGE(PG8_SB(0, 0), b2, voffB); PG8_STAGE(PG8_SB(0, 1), b2 + hstep, voffB); PG8_STAGE(PG8_SA(0, 0), a2, voffA);
            PG8_WAIT_V(8); PG8_WAIT_L(0); PG8_BAR; PG8_MMA(1, 0, At, B0); PG8_MMA(1, 1, At, B1); PG8_BAR; PG8_SCHED;
            PG8_LDB(B0, 1, 0); PG8_LDB(B1, 1, 1); PG8_SCHED; PG8_LDA(At, 1, 0); PG8_STAGE(PG8_SA(0, 1), a2 + hstep, voffA);
            PG8_WAIT_V(8); PG8_WAIT_L(0); PG8_BAR; PG8_MMA(0, 0, At, B0); PG8_MMA(0, 1, At, B1); PG8_BAR; PG8_SCHED;
            PG8_LDA(At, 1, 1); PG8_STAGE(PG8_SB(1, 0), b3, voffB); PG8_STAGE(PG8_SB(1, 1), b3 + hstep, voffB); PG8_STAGE(PG8_SA(1, 0), a3, voffA);
            PG8_WAIT_V(8); PG8_WAIT_L(0); PG8_BAR; PG8_MMA(1, 0, At, B0); PG8_MMA(1, 1, At, B1); PG8_BAR; PG8_SCHED;
            } else {
            PG8_LDB(B0, 0, 0); PG8_SCHED; PG8_LDA(At, 0, 0); PG8_STAGE(PG8_SA(1, 1), a1 + hstep, voffA);
            PG8_WAIT_L(8); PG8_BAR; PG8_WAIT_L(0); PG8_MMA(0, 0, At, B0); PG8_BAR; PG8_SCHED;
            PG8_LDB(B1, 0, 1); PG8_STAGE(PG8_SB(0, 0), b2, voffB);
            PG8_BAR; PG8_WAIT_L(0); PG8_MMA(0, 1, At, B1); PG8_BAR;
            PG8_LDA(At, 0, 1); PG8_STAGE(PG8_SA(0, 0), a2, voffA);
            PG8_BAR; PG8_WAIT_L(0); PG8_MMA(1, 0, At, B0); PG8_BAR; PG8_SCHED;
            PG8_STAGE(PG8_SB(0, 1), b2 + hstep, voffB);
            PG8_WAIT_V(6); PG8_BAR; PG8_MMA(1, 1, At, B1); PG8_BAR;
            PG8_LDB(B0, 1, 0); PG8_SCHED; PG8_LDA(At, 1, 0); PG8_STAGE(PG8_SA(0, 1), a2 + hstep, voffA);
            PG8_WAIT_L(8); PG8_BAR; PG8_WAIT_L(0); PG8_MMA(0, 0, At, B0); PG8_BAR; PG8_SCHED;
            PG8_LDB(B1, 1, 1); PG8_STAGE(PG8_SB(1, 0), b3, voffB);
            PG8_BAR; PG8_WAIT_L(0); PG8_MMA(0, 1, At, B1); PG8_BAR;
            PG8_LDA(At, 1, 1); PG8_STAGE(PG8_SA(1, 0), a3, voffA);
            PG8_BAR; PG8_WAIT_L(0); PG8_MMA(1, 0, At, B0); PG8_BAR; PG8_SCHED;
            PG8_STAGE(PG8_SB(1, 1), b3 + hstep, voffB);
            PG8_WAIT_V(6); PG8_BAR; PG8_MMA(1, 1, At, B1); PG8_BAR;
            }
        }
        if constexpr (ALIGN_EPI) { if (wr == 0) PG8_BAR; }
        if constexpr (!Epi::AFTER_DRAIN) { E(acc, cur, wr, wc, fr, fq); S.done(cur); }
        if (!has_next) break;
#pragma unroll
        for (int a = 0; a < 2; ++a)
#pragma unroll
            for (int b = 0; b < 2; ++b)
#pragma unroll
                for (int m = 0; m < 4; ++m)
#pragma unroll
                    for (int n = 0; n < 2; ++n) acc[a][b][m][n] = (f32x4){0.f, 0.f, 0.f, 0.f};
        cur = nxt; cA = nA; cB = nB; ++ui;
        if constexpr (ALIGN_EPI) { if (wr == 1) PG8_BAR; }
    }
    PG8_WAIT_V(0);
    if constexpr (!ALIGN_EPI) { if (wr == 0) PG8_BAR; }
    PG8_BAR;
    if constexpr (Epi::AFTER_DRAIN) { E.fused(acc, cur, wr, wc, fr, fq, lds, wid, lane); S.done(cur); }
#undef PG8_SW
#undef PG8_BASEA
#undef PG8_BASEB
#undef PG8_SA
#undef PG8_SB
#undef PG8_STAGE
#undef PG8_LDA
#undef PG8_LDB
#undef PG8_MMA
#undef PG8_WAIT_V
#undef PG8_WAIT_L
#undef PG8_BAR
#undef PG8_SCHED
}
}
constexpr int BATCH = 2, SEQ = 4096, DM = 2048, MTOK = BATCH * SEQ;
constexpr int NIN = 7680;
constexpr int FF = 5632, NCHUNK = 64;
constexpr int W_IN_LD = 7184;
constexpr float NORM_EPS = 1e-6f;
constexpr int NWAVES = 8;
constexpr size_t MiB = 1u << 20;
constexpr size_t WS_MODFIX = 0;
constexpr size_t WS_BAR = 200 * 1024;
constexpr size_t CTL_ZERO_BYTES = 256 * 1024;
constexpr size_t WS_MODF = 512 * 1024;
constexpr size_t WS_WIN = 1 * MiB, WS_WOUT = 31 * MiB, WS_WFIN = 39 * MiB, WS_WFOUT = 83 * MiB;
constexpr size_t WS_H = 105 * MiB;
constexpr size_t WS_QT = 137 * MiB, WS_KT = 161 * MiB, WS_VT = 185 * MiB;
constexpr size_t WS_GT = 217 * MiB;
constexpr size_t WS_GG = 265 * MiB;
constexpr size_t WS_ST = 297 * MiB;
constexpr size_t WS_HID = 137 * MiB;
constexpr size_t WS_END = 361 * MiB;
constexpr int LDS_BYTES = 147456;

#define GAS __attribute__((address_space(1)))
#define LAS __attribute__((address_space(3)))
typedef unsigned short bf16;
typedef unsigned u32x4 __attribute__((ext_vector_type(4)));
typedef unsigned u32x2 __attribute__((ext_vector_type(2)));
typedef float f32x4 __attribute__((ext_vector_type(4)));
typedef short bf16x8 __attribute__((ext_vector_type(8)));
typedef short s16x4 __attribute__((ext_vector_type(4)));
#define LDS_WAIT() asm volatile("s_waitcnt lgkmcnt(0)" ::: "memory")
__device__ __forceinline__ unsigned pk2(float lo, float hi) { return pg8::cvt_pk_bf16(lo, hi); }
__device__ __forceinline__ float bf_lo(unsigned w) { return __uint_as_float(w << 16); }
__device__ __forceinline__ float bf_hi(unsigned w) { return __uint_as_float(w & 0xffff0000u); }
__device__ __forceinline__ float wave_sum(float v) {
#pragma unroll
    for (int o = 1; o < 64; o <<= 1) v += __shfl_xor(v, o);
    return v;
}

struct Frame {
    LAS unsigned char* lds;
    int tid, lane, wave, G;
    const float *x, *c, *w_ada, *b_ada, *norm_mix_w, *w_in, *w_gate, *b_gate, *gla_norm_w, *lbl, *hg_norm_w, *w_out, *norm_ffn_w, *w_ffn_in, *w_ffn_out, *final_w;
    float* out;
    long long* modfix; float* modf;
    bf16 *WinT, *WoutT, *WfinT, *WfoutT, *H, *QT, *KT, *VT, *GG, *ST, *HID;
    float* GT;
};

__device__ __forceinline__ void p0_transpose_item(const float* W, int ldw, int src0, int k0, bf16* WT, int K, int n0, LAS float* scr, int lane) {
    const int l15 = lane & 15, lq = lane >> 4;
#pragma unroll 4
    for (int i = 0; i < 16; ++i) { const int kk = 4 * i + lq; const f32x4 v = *(const f32x4*)(W + (size_t)(k0 + kk) * ldw + src0 + 4 * l15);
        LAS float* s = scr + kk * 65 + 4 * l15; s[0] = v[0]; s[1] = v[1]; s[2] = v[2]; s[3] = v[3]; }
    LDS_WAIT(); asm volatile("" ::: "memory");
    const int c = lane & 7;
#pragma unroll
    for (int j = 0; j < 8; ++j) { const int n = 8 * j + (lane >> 3); const LAS float* s = scr + (8 * c) * 65 + n;
        u32x4 o; o.x = pk2(s[0 * 65], s[1 * 65]); o.y = pk2(s[2 * 65], s[3 * 65]); o.z = pk2(s[4 * 65], s[5 * 65]); o.w = pk2(s[6 * 65], s[7 * 65]);
        *(u32x4*)(WT + (size_t)(n0 + n) * K + k0 + 8 * c) = o; }
    LDS_WAIT(); asm volatile("" ::: "memory");
}
__device__ __forceinline__ void p0_prologue(Frame& F) {
    LAS float* scr = (LAS float*)(F.lds) + F.wave * (64 * 65);
    const int gw = blockIdx.x * NWAVES + F.wave, NGW = F.G * NWAVES;
    constexpr int I_IN = 112 * 32, I_OUT = 32 * 32, I_FIN = 176 * 32, I_FOUT = 32 * 88, I_T = I_IN + I_OUT + I_FIN + I_FOUT, I_GEMV = 48 * 32;
    for (int it = gw; it < I_T + I_GEMV; it += NGW) {
        int r = it;
        if (r < I_IN) { const int kb = r / 112, nb = r % 112; const int n0 = nb < 48 ? 64 * nb : 3584 + 64 * (nb - 48); const int src0 = nb < 48 ? n0 : n0 - 496;
            p0_transpose_item(F.w_in, W_IN_LD, src0, 64 * kb, F.WinT, DM, n0, scr, F.lane); continue; } r -= I_IN;
        if (r < I_OUT) { const int kb = r / 32, nb = r % 32; p0_transpose_item(F.w_out, DM, 64 * nb, 64 * kb, F.WoutT, DM, 64 * nb, scr, F.lane); continue; } r -= I_OUT;
        if (r < I_FIN) { const int kb = r / 176, nb = r % 176; const int n0 = 64 * nb, t = n0 >> 8, w = n0 & 255; const int src0 = w < 128 ? 128 * t + w : FF + 128 * t + (w - 128);
            p0_transpose_item(F.w_ffn_in, 2 * FF, src0, 64 * kb, F.WfinT, DM, n0, scr, F.lane); continue; } r -= I_FIN;
        if (r < I_FOUT) { const int kb = r / 32, nb = r % 32; p0_transpose_item(F.w_ffn_out, DM, 64 * nb, 64 * kb, F.WfoutT, FF, 64 * nb, scr, F.lane); continue; } r -= I_FOUT;
        { const int cb = r % 48, ks = r / 48, k0 = 64 * ks, col = 256 * cb + 4 * F.lane;
          f32x4 a0 = {0.f, 0.f, 0.f, 0.f}, a1 = {0.f, 0.f, 0.f, 0.f};
#pragma unroll 8
          for (int kk = 0; kk < 64; ++kk) { const f32x4 w = *(const f32x4*)(F.w_ada + (size_t)(k0 + kk) * 12288 + col);
              const float c0 = F.c[k0 + kk], c1 = F.c[DM + k0 + kk]; const float s0 = c0 / (1.0f + __expf(-c0)), s1 = c1 / (1.0f + __expf(-c1));
              a0 += w * s0; a1 += w * s1; }
          if (ks == 0) { const f32x4 bv = *(const f32x4*)(F.b_ada + col); a0 += bv; a1 += bv; }
#pragma unroll
          for (int e = 0; e < 4; ++e) {
              atomicAdd((unsigned long long*)(F.modfix + col + e), (unsigned long long)__float2ll_rn(a0[e] * 4294967296.0f));
              atomicAdd((unsigned long long*)(F.modfix + 12288 + col + e), (unsigned long long)__float2ll_rn(a1[e] * 4294967296.0f)); }
        }
    }
    for (int id = blockIdx.x * 512 + F.tid; id < 512 * 256; id += F.G * 512) { const int n = id & 511, k8 = id >> 9;
        float wg[16];
#pragma unroll
        for (int r = 0; r < 16; ++r) wg[r] = F.w_gate[r * 512 + n];
        float o[8];
#pragma unroll
        for (int i = 0; i < 8; ++i) { const float* wr_ = F.w_in + (size_t)(8 * k8 + i) * W_IN_LD + 3072; float s = 0.f;
#pragma unroll
            for (int q = 0; q < 4; ++q) { const f32x4 v = *(const f32x4*)(wr_ + 4 * q); s += v[0] * wg[4 * q] + v[1] * wg[4 * q + 1] + v[2] * wg[4 * q + 2] + v[3] * wg[4 * q + 3]; }
            o[i] = s; }
        u32x4 w; w.x = pk2(o[0], o[1]); w.y = pk2(o[2], o[3]); w.z = pk2(o[4], o[5]); w.w = pk2(o[6], o[7]);
        *(u32x4*)(F.WinT + (size_t)(3072 + n) * DM + 8 * k8) = w; }
}
__device__ __forceinline__ float modfix_get(const long long* p) { return (float)(*p) * 2.3283064365386963e-10f; }

template <bool FROM_FIX>
__device__ __forceinline__ void norm_mod_rows(Frame& F, const float* X, const float* nw, int shift_off, int scale_off, bf16* O) {
    const int gw = blockIdx.x * NWAVES + F.wave, NGW = F.G * NWAVES;
    for (int m = gw; m < MTOK; m += NGW) { const int b = m >> 12;
        const f32x4* xr = (const f32x4*)(X + (size_t)m * DM) + F.lane;
        f32x4 v[8]; float ss = 0.f;
#pragma unroll
        for (int j = 0; j < 8; ++j) { v[j] = xr[64 * j]; ss += (v[j][0] * v[j][0] + v[j][1] * v[j][1]) + (v[j][2] * v[j][2] + v[j][3] * v[j][3]); }
        const float rinv = rsqrtf(wave_sum(ss) * (1.0f / DM) + NORM_EPS);
        u32x2* o8 = (u32x2*)(O + (size_t)m * DM) + F.lane;
#pragma unroll
        for (int j = 0; j < 8; ++j) { const int col = 256 * j + 4 * F.lane; const f32x4 w = *(const f32x4*)(nw + col); f32x4 sc, sh;
            if (FROM_FIX) { const long long* ps = F.modfix + b * 12288 + scale_off + col; const long long* ph = F.modfix + b * 12288 + shift_off + col;
#pragma unroll
                for (int e = 0; e < 4; ++e) { sc[e] = modfix_get(ps + e); sh[e] = modfix_get(ph + e); } }
            else { sc = *(const f32x4*)(F.modf + b * 12288 + scale_off + col); sh = *(const f32x4*)(F.modf + b * 12288 + shift_off + col); }
            const f32x4 y = (v[j] * rinv) * w * (sc + 1.0f) + sh;
            u32x2 p; p.x = pk2(y[0], y[1]); p.y = pk2(y[2], y[3]); o8[64 * j] = p; }
    }
}
__device__ __forceinline__ void final_norm_rows(Frame& F) {
    const int gw = blockIdx.x * NWAVES + F.wave, NGW = F.G * NWAVES;
    for (int m = gw; m < MTOK; m += NGW) {
        f32x4* xr = (f32x4*)(F.out + (size_t)m * DM) + F.lane;
        f32x4 v[8]; float ss = 0.f;
#pragma unroll
        for (int j = 0; j < 8; ++j) { v[j] = xr[64 * j]; ss += (v[j][0] * v[j][0] + v[j][1] * v[j][1]) + (v[j][2] * v[j][2] + v[j][3] * v[j][3]); }
        const float rinv = rsqrtf(wave_sum(ss) * (1.0f / DM) + NORM_EPS);
#pragma unroll
        for (int j = 0; j < 8; ++j) { const f32x4 w = *(const f32x4*)(F.final_w + 256 * j + 4 * F.lane); xr[64 * j] = (v[j] * rinv) * w; }
    }
}
__device__ __forceinline__ void s1_phase(Frame& F) {
    const int lane = F.lane, c = lane & 15, g = lane >> 4, w = F.wave;
    LAS unsigned char* AF = F.lds;
    LAS float* DEC = (LAS float*)(F.lds + 32768);
    for (int u = blockIdx.x; u < 256; u += F.G) {
        int b, krow0, vrow0, dkb;
        if (u < 128) { const int half = u & 1, h = (u >> 4) & 3; dkb = (u >> 1) & 7; b = u >> 6; krow0 = 128 * h + 16 * dkb; vrow0 = 256 * h + 128 * half + 16 * w; }
        else { const int v = u - 128, h = (v >> 3) & 7; dkb = v & 7; b = v >> 6; krow0 = 512 + 128 * h + 16 * dkb; vrow0 = 1024 + 128 * h + 16 * w; }
        const bf16* kp = F.KT + (size_t)(krow0 + c) * MTOK + b * SEQ + 8 * g;
        const float* gp = F.GT + (size_t)(krow0 + c) * MTOK + b * SEQ + 8 * g;
        const bf16* vp = F.VT + (size_t)(vrow0 + c) * MTOK + b * SEQ + 8 * g;
        bf16* sp = F.ST + ((size_t)(b * NCHUNK) * 2048 + vrow0 + c) * 128 + 16 * dkb + 4 * g;
        f32x4 S = {0.f, 0.f, 0.f, 0.f};
        u32x4 pk[2]; f32x4 pg[2][2]; bf16x8 Vc[8][2], Vn[8][2];
#define S1_PREP_LOAD(n_) do { _Pragma("unroll") for (int s = 0; s < 2; ++s) { pk[s] = *(const u32x4*)(kp + 64 * (n_) + 32 * s); pg[s][0] = *(const f32x4*)(gp + 64 * (n_) + 32 * s); pg[s][1] = *(const f32x4*)(gp + 64 * (n_) + 32 * s + 4); } } while (0)
        S1_PREP_LOAD(w);
#pragma unroll
        for (int i = 0; i < 8; ++i) { Vc[i][0] = *(const bf16x8*)(vp + 64 * i); Vc[i][1] = *(const bf16x8*)(vp + 64 * i + 32); }
        __syncthreads();
        for (int m = 0; m < 8; ++m) {
            {
                float p[2][8];
#pragma unroll
                for (int s = 0; s < 2; ++s) { float a = 0.f;
#pragma unroll
                    for (int t = 0; t < 8; ++t) { a += pg[s][t >> 2][t & 3]; p[s][t] = a; } }
                float t0[4], t1[4];
#pragma unroll
                for (int q = 0; q < 4; ++q) { t0[q] = __shfl(p[0][7], 16 * q + c); t1[q] = __shfl(p[1][7], 16 * q + c); }
                const float sum0 = (t0[0] + t0[1]) + (t0[2] + t0[3]);
                const float off0 = (g > 0 ? t0[0] : 0.f) + (g > 1 ? t0[1] : 0.f) + (g > 2 ? t0[2] : 0.f);
                const float off1 = sum0 + (g > 0 ? t1[0] : 0.f) + (g > 1 ? t1[1] : 0.f) + (g > 2 ? t1[2] : 0.f);
                const float blast = sum0 + (t1[0] + t1[1]) + (t1[2] + t1[3]);
                LAS u32x4* afw = (LAS u32x4*)(AF + (m & 1) * 16384 + w * 2048 + lane * 16);
#pragma unroll
                for (int s = 0; s < 2; ++s) { const float off = s == 0 ? off0 : off1; unsigned ww[4];
#pragma unroll
                    for (int t = 0; t < 8; t += 2) { const unsigned kw = pk[s][t >> 1];
                        ww[t >> 1] = pk2(bf_lo(kw) * __expf(blast - (p[s][t] + off)), bf_hi(kw) * __expf(blast - (p[s][t + 1] + off))); }
                    afw[64 * s] = (u32x4){ww[0], ww[1], ww[2], ww[3]}; }
                if (g == 0) DEC[(m & 1) * 128 + w * 16 + c] = __expf(blast);
            }
            const int mn = m < 7 ? m + 1 : 7;
            S1_PREP_LOAD(8 * mn + w);
            __syncthreads();
#pragma unroll
            for (int i = 0; i < 8; ++i) { Vn[i][0] = *(const bf16x8*)(vp + 64 * (8 * mn + i)); Vn[i][1] = *(const bf16x8*)(vp + 64 * (8 * mn + i) + 32); }
            const LAS unsigned char* afr = AF + (m & 1) * 16384 + lane * 16; const LAS float* der = DEC + (m & 1) * 128 + 4 * g;
#pragma unroll
            for (int i = 0; i < 8; ++i) {
                { u32x2 sw; sw.x = pk2(S[0], S[1]); sw.y = pk2(S[2], S[3]); *(u32x2*)(sp + (size_t)(8 * m + i) * (2048 * 128)) = sw; }
                const bf16x8 a0 = *(const LAS bf16x8*)(afr + i * 2048), a1 = *(const LAS bf16x8*)(afr + i * 2048 + 1024);
                const f32x4 dec = *(const LAS f32x4*)(der + i * 16);
                S = S * dec;
                S = __builtin_amdgcn_mfma_f32_16x16x32_bf16(a0, Vc[i][0], S, 0, 0, 0);
                S = __builtin_amdgcn_mfma_f32_16x16x32_bf16(a1, Vc[i][1], S, 0, 0, 0);
            }
#pragma unroll
            for (int i = 0; i < 8; ++i) { Vc[i][0] = Vn[i][0]; Vc[i][1] = Vn[i][1]; }
        }
#undef S1_PREP_LOAD
    }
}

__device__ __forceinline__ s16x4 tr16(LAS const unsigned char* p) { typedef short v4i16_t __attribute__((ext_vector_type(4))); return __builtin_bit_cast(s16x4, __builtin_amdgcn_ds_read_tr16_b64_v4i16((LAS v4i16_t*)p)); }
struct S2In { u32x4 q0, q1, k0, k1; f32x4 gv[4]; };
__device__ __forceinline__ void s2_load_in(S2In& I, const Frame& F, int u) {
    const int hh = u >> 7, b = (u >> 6) & 1, n = u & 63, d = F.tid >> 2, tg = F.tid & 3;
    const size_t off = (size_t)(128 * hh + d) * MTOK + b * SEQ + 64 * n + 16 * tg;
    I.q0 = *(const u32x4*)(F.QT + off); I.q1 = *(const u32x4*)(F.QT + off + 8); I.k0 = *(const u32x4*)(F.KT + off); I.k1 = *(const u32x4*)(F.KT + off + 8);
#pragma unroll
    for (int i = 0; i < 4; ++i) I.gv[i] = *(const f32x4*)(F.GT + off + 4 * i);
}
__device__ __forceinline__ void s2_phase(Frame& F) {
    constexpr int IST = 144;
    LAS unsigned char* QI = F.lds; LAS unsigned char* KI = F.lds + 128 * IST; LAS float* red = (LAS float*)(F.lds + 2 * 128 * IST);
    const int tid = F.tid, lane = F.lane, wave = F.wave, c = lane & 15, g = lane >> 4, it = wave & 3, eh = wave >> 2;
    const int tq = c >> 2, tp = c & 3;
    if ((int)blockIdx.x >= 12 * 128) return;
    S2In cur, nxt;
    s2_load_in(cur, F, blockIdx.x);
    __syncthreads();
    for (int u = blockIdx.x; u < 12 * 128; u += F.G) {
        const int hh = u >> 7, b = (u >> 6) & 1, n = u & 63;
        const bool gla = hh < 4;
        const int vrow0 = gla ? 256 * hh : 1024 + 128 * (hh - 4), dv = gla ? 256 : 128;
        const int tok0 = b * SEQ + 64 * n;
        {
            const int d = tid >> 2, tg = tid & 3;
            float p[16]; float a = 0.f;
#pragma unroll
            for (int i = 0; i < 16; ++i) { a += cur.gv[i >> 2][i & 3]; p[i] = a; }
            const float s1 = __shfl_up(a, 1), s2 = __shfl_up(a, 2), s3 = __shfl_up(a, 3);
            const float offb = (tg > 0 ? s1 : 0.f) + (tg > 1 ? s2 : 0.f) + (tg > 2 ? s3 : 0.f);
            unsigned qo[8], ko[8];
#pragma unroll
            for (int i = 0; i < 8; ++i) { const unsigned qw = i < 4 ? cur.q0[i & 3] : cur.q1[i & 3], kw = i < 4 ? cur.k0[i & 3] : cur.k1[i & 3];
                const float b0 = p[2 * i] + offb, b1 = p[2 * i + 1] + offb;
                qo[i] = pk2(bf_lo(qw) * __expf(b0), bf_hi(qw) * __expf(b1)); ko[i] = pk2(bf_lo(kw) * __expf(-b0), bf_hi(kw) * __expf(-b1)); }
            LAS u32x4* qd = (LAS u32x4*)(QI + d * IST + 32 * tg); LAS u32x4* kd = (LAS u32x4*)(KI + d * IST + 32 * tg);
            qd[0] = (u32x4){qo[0], qo[1], qo[2], qo[3]}; qd[1] = (u32x4){qo[4], qo[5], qo[6], qo[7]};
            kd[0] = (u32x4){ko[0], ko[1], ko[2], ko[3]}; kd[1] = (u32x4){ko[4], ko[5], ko[6], ko[7]};
        }
        { const int un = u + F.G < 12 * 128 ? u + F.G : u; s2_load_in(nxt, F, un); }
        const int ebase = eh * (dv >> 1);
        const bf16* stp = F.ST + ((size_t)(b * NCHUNK + n) * 2048 + vrow0 + ebase + c) * 128 + 8 * g;
        const bf16* vtp = F.VT + (size_t)(vrow0 + ebase + c) * MTOK + tok0 + 4 * g;
        const size_t orow = (size_t)(tok0 + 16 * it + c) * DM + vrow0 + ebase + 4 * g;
        bf16x8 sa[4][4]; s16x4 va[4][4]; u32x2 gg[4];
#define S2_LOAD_BATCH(e0) do { _Pragma("unroll") for (int t = 0; t < 4; ++t) { \
            _Pragma("unroll") for (int s = 0; s < 4; ++s) sa[t][s] = *(const bf16x8*)(stp + (size_t)(16 * ((e0) + t)) * 128 + 32 * s); \
            _Pragma("unroll") for (int s = 0; s < 2; ++s) { va[t][2 * s] = *(const s16x4*)(vtp + (size_t)(16 * ((e0) + t)) * MTOK + 32 * s); va[t][2 * s + 1] = *(const s16x4*)(vtp + (size_t)(16 * ((e0) + t)) * MTOK + 32 * s + 16); } \
            gg[t] = *(const u32x2*)(F.GG + orow + 16 * ((e0) + t)); } } while (0)
        S2_LOAD_BATCH(0);
        __syncthreads();
        bf16x8 qf[4];
#pragma unroll
        for (int s = 0; s < 4; ++s) { const s16x4 lo = tr16(QI + (32 * s + 8 * g + tq) * IST + 32 * it + 8 * tp), hi = tr16(QI + (32 * s + 8 * g + 4 + tq) * IST + 32 * it + 8 * tp);
            qf[s] = __builtin_shufflevector(lo, hi, 0, 1, 2, 3, 4, 5, 6, 7); }
        f32x4 sT[4];
#pragma unroll
        for (int jt = 0; jt < 4; ++jt) { f32x4 acc = {0.f, 0.f, 0.f, 0.f};
#pragma unroll
            for (int s = 0; s < 4; ++s) { const s16x4 lo = tr16(KI + (32 * s + 8 * g + tq) * IST + 32 * jt + 8 * tp), hi = tr16(KI + (32 * s + 8 * g + 4 + tq) * IST + 32 * jt + 8 * tp);
                const bf16x8 kf = __builtin_shufflevector(lo, hi, 0, 1, 2, 3, 4, 5, 6, 7);
                acc = __builtin_amdgcn_mfma_f32_16x16x32_bf16(kf, qf[s], acc, 0, 0, 0); }
#pragma unroll
            for (int r = 0; r < 4; ++r) { const bool keep = (jt < it) || (jt == it && 4 * g + r <= c); acc[r] = keep ? acc[r] : 0.f; }
            sT[jt] = acc; }
        bf16x8 pb[2];
#pragma unroll
        for (int s = 0; s < 2; ++s) { u32x4 w; w.x = pk2(sT[2 * s][0], sT[2 * s][1]); w.y = pk2(sT[2 * s][2], sT[2 * s][3]); w.z = pk2(sT[2 * s + 1][0], sT[2 * s + 1][1]); w.w = pk2(sT[2 * s + 1][2], sT[2 * s + 1][3]);
            pb[s] = __builtin_bit_cast(bf16x8, w); }
        f32x4 o[8]; float gl[8][4]; float ss = 0.f;
#define S2_MMA_BATCH(e0) do { _Pragma("unroll") for (int t = 0; t < 4; ++t) { f32x4 acc = {0.f, 0.f, 0.f, 0.f}; \
            _Pragma("unroll") for (int s = 0; s < 4; ++s) acc = __builtin_amdgcn_mfma_f32_16x16x32_bf16(sa[t][s], qf[s], acc, 0, 0, 0); \
            _Pragma("unroll") for (int s = 0; s < 2; ++s) { const bf16x8 a = __builtin_shufflevector(va[t][2 * s], va[t][2 * s + 1], 0, 1, 2, 3, 4, 5, 6, 7); acc = __builtin_amdgcn_mfma_f32_16x16x32_bf16(a, pb[s], acc, 0, 0, 0); } \
            o[(e0) + t] = acc; ss += (acc[0] * acc[0] + acc[1] * acc[1]) + (acc[2] * acc[2] + acc[3] * acc[3]); \
            gl[(e0) + t][0] = bf_lo(gg[t].x); gl[(e0) + t][1] = bf_hi(gg[t].x); gl[(e0) + t][2] = bf_lo(gg[t].y); gl[(e0) + t][3] = bf_hi(gg[t].y); } } while (0)
        S2_MMA_BATCH(0);
        if (gla) { S2_LOAD_BATCH(4); S2_MMA_BATCH(4); }
        ss += __shfl_xor(ss, 16); ss += __shfl_xor(ss, 32);
        if (g == 0) red[wave * 16 + c] = ss;
        __syncthreads();
        const float tot = red[wave * 16 + c] + red[(wave ^ 4) * 16 + c];
        const float rinv = rsqrtf(tot / (float)dv + NORM_EPS);
        const float* nw = gla ? F.gla_norm_w : F.hg_norm_w;
#pragma unroll
        for (int et = 0; et < 8; ++et) if (et < 4 || gla) { const f32x4 w = *(const f32x4*)(nw + ebase + 16 * et + 4 * g);
            const f32x4 y = o[et] * rinv * w; u32x2 p; p.x = pk2(y[0] * gl[et][0], y[1] * gl[et][1]); p.y = pk2(y[2] * gl[et][2], y[3] * gl[et][3]);
            *(u32x2*)(F.H + orow + 16 * et) = p; }
        cur = nxt;
#undef S2_LOAD_BATCH
#undef S2_MMA_BATCH
    }
}
#define XB_TMO      128
#define XB_XCNT(j)  (256  + 64 * (j))
#define XB_XSUB(j)  (1280 + 64 * (j))
#define XB_XGEN(j)  (2304 + 64 * (j))
#define XB_TOP      3328
#define XB_TOPGEN   3392
#define XCD_BAR_WORDS 3456
#define XB_SPIN_CAP (1u << 18)

__device__ __forceinline__ unsigned xb_ld(unsigned* p)              { return __hip_atomic_load(p, __ATOMIC_RELAXED, __HIP_MEMORY_SCOPE_AGENT); }
__device__ __forceinline__ unsigned xb_add(unsigned* p, unsigned v) { return __hip_atomic_fetch_add(p, v, __ATOMIC_RELAXED, __HIP_MEMORY_SCOPE_AGENT); }
__device__ __forceinline__ unsigned xb_xcc_id() { return (unsigned)__builtin_amdgcn_s_getreg((3 << 11) | 20) & 0xFu; }
#define XB_SPIN(cond, bar) do { unsigned _sp = 0; while (cond) { __builtin_amdgcn_s_sleep(1); \
    if ((++_sp & 255u) == 0u) { if (xb_ld(&(bar)[XB_TMO])) break; if (_sp > XB_SPIN_CAP) { atomicAdd(&(bar)[XB_TMO], 1u); break; } } } } while (0)

struct XcdBarrier {
    unsigned* bar; unsigned x;
    volatile LAS unsigned* st;
};

__device__ __forceinline__ XcdBarrier xcd_barrier_post(unsigned* bar, volatile LAS unsigned* st) {
    XcdBarrier b; b.bar = bar; b.x = xb_xcc_id(); b.st = st;
    if (threadIdx.x == 0) (void)xb_add(&bar[XB_XCNT(b.x)], 1u);
    return b;
}
__device__ __forceinline__ void xcd_barrier_complete(unsigned* bar, unsigned x, unsigned& nloc, unsigned& nx) {
    const unsigned G = gridDim.x * gridDim.y * gridDim.z;
    unsigned sum, cnt, mine, sp = 0u;
    for (;;) {
        sum = 0u; cnt = 0u; mine = 0u;
#pragma unroll
        for (unsigned j = 0; j < 16; ++j) { const unsigned c = xb_ld(&bar[XB_XCNT(j)]); sum += c; cnt += (c > 0u) ? 1u : 0u; mine = (j == x) ? c : mine; }
        if (sum == G) break;
        __builtin_amdgcn_s_sleep(1);
        if ((++sp & 255u) == 0u) { if (xb_ld(&bar[XB_TMO])) break; if (sp > XB_SPIN_CAP) { atomicAdd(&bar[XB_TMO], 1u); break; } }
    }
    nloc = mine > 0u ? mine : 1u; nx = cnt > 0u ? cnt : 1u;
}

__device__ __forceinline__ void xcd_barrier(const XcdBarrier& b) {
    asm volatile("s_waitcnt vmcnt(0)" ::: "memory");
    __syncthreads();
    if (threadIdx.x == 0) {
        unsigned* bar = b.bar;
        __builtin_amdgcn_s_waitcnt(0);
        unsigned nloc = b.st[0], nx = b.st[1];
        if (nloc == 0u) { xcd_barrier_complete(bar, b.x, nloc, nx); b.st[0] = nloc; b.st[1] = nx; }
        const unsigned old = xb_add(&bar[XB_XSUB(b.x)], 1u);
        const unsigned gen = old / nloc;
        if (old + 1u == (gen + 1u) * nloc) {
            __builtin_amdgcn_fence(__ATOMIC_RELEASE, "agent");
            asm volatile("s_waitcnt vmcnt(0)" ::: "memory");
            const unsigned og = xb_add(&bar[XB_TOP], 1u);
            const unsigned tg = og / nx;
            if (og + 1u == (tg + 1u) * nx) xb_add(&bar[XB_TOPGEN], 1u);
            else XB_SPIN(xb_ld(&bar[XB_TOPGEN]) == tg, bar);
            __builtin_amdgcn_fence(__ATOMIC_ACQUIRE, "agent");
            xb_add(&bar[XB_XGEN(b.x)], 1u);
            asm volatile("s_waitcnt vmcnt(0)" ::: "memory");
        } else {
            XB_SPIN(xb_ld(&bar[XB_XGEN(b.x)]) == gen, bar);
            __builtin_amdgcn_fence(__ATOMIC_ACQUIRE, "agent");
            asm volatile("s_waitcnt vmcnt(0)" ::: "memory");
        }
    }
    __syncthreads();
}
struct Args { const float* in[16]; float* out; unsigned char* ws; };
__global__ void __launch_bounds__(NWAVES * 64, 2) fwd_megakernel(Args args) {
    extern __shared__ __attribute__((aligned(16))) unsigned char lds_raw[];
    cg::grid_group grid = cg::this_grid();
    Frame F;
    F.lds = (LAS unsigned char*)lds_raw;
    F.tid = threadIdx.x; F.lane = F.tid & 63; F.wave = __builtin_amdgcn_readfirstlane(F.tid >> 6); F.G = gridDim.x;
    F.x = args.in[0]; F.c = args.in[1]; F.w_ada = args.in[2]; F.b_ada = args.in[3]; F.norm_mix_w = args.in[4]; F.w_in = args.in[5]; F.w_gate = args.in[6]; F.b_gate = args.in[7];
    F.gla_norm_w = args.in[8]; F.lbl = args.in[9]; F.hg_norm_w = args.in[10]; F.w_out = args.in[11]; F.norm_ffn_w = args.in[12]; F.w_ffn_in = args.in[13]; F.w_ffn_out = args.in[14]; F.final_w = args.in[15];
    F.out = args.out;
    unsigned char* ws = args.ws;
    F.modfix = (long long*)(ws + WS_MODFIX); F.modf = (float*)(ws + WS_MODF);
    F.WinT = (bf16*)(ws + WS_WIN); F.WoutT = (bf16*)(ws + WS_WOUT); F.WfinT = (bf16*)(ws + WS_WFIN); F.WfoutT = (bf16*)(ws + WS_WFOUT);
    F.H = (bf16*)(ws + WS_H); F.QT = (bf16*)(ws + WS_QT); F.KT = (bf16*)(ws + WS_KT); F.VT = (bf16*)(ws + WS_VT); F.GT = (float*)(ws + WS_GT);
    F.GG = (bf16*)(ws + WS_GG); F.ST = (bf16*)(ws + WS_ST); F.HID = (bf16*)(ws + WS_HID);

    volatile LAS unsigned* MISC = (volatile LAS unsigned*)(F.lds + 139264);
    if (F.tid < 16) MISC[F.tid] = 0u;
    __syncthreads();
    const XcdBarrier bar = xcd_barrier_post((unsigned*)(ws + WS_BAR), MISC + 8);
    if (ws == nullptr) grid.sync();
#define GRID_BAR() xcd_barrier(bar)
    p0_prologue(F);
    GRID_BAR();
    for (int id = blockIdx.x * 512 + F.tid; id < 2 * 12288; id += F.G * 512) F.modf[id] = modfix_get(F.modfix + id);
    norm_mod_rows<true>(F, F.x, F.norm_mix_w, 0, 2048, F.H);
    GRID_BAR();
    {   pg8::Gemm g{F.H, F.WinT, MTOK, NIN, DM, 0x03FFF0FFu}; pg8::StaticOrder S; S.init(MTOK, NIN, F.G, (int)blockIdx.x);
        pg8::EpiInProj E{F.QT, F.KT, F.VT, F.GT, F.GG, F.b_gate, F.lbl};
        pg8::gemm_phase<pg8::EpiInProj, pg8::StaticOrder, true, true>(F.lds, g, S, E); }
    GRID_BAR();
    s1_phase(F);
    GRID_BAR();
    s2_phase(F);
    GRID_BAR();
    {   pg8::Gemm g{F.H, F.WoutT, MTOK, DM, DM, 0u}; pg8::StaticOrder S; S.init(MTOK, DM, F.G, (int)blockIdx.x);
        pg8::EpiResid E{F.x, F.out, F.modf + 4096};
        pg8::gemm_phase<pg8::EpiResid, pg8::StaticOrder, true, true>(F.lds, g, S, E); }
    GRID_BAR();
    norm_mod_rows<false>(F, F.out, F.norm_ffn_w, 6144, 8192, F.H);
    GRID_BAR();
    {   pg8::Gemm g{F.H, F.WfinT, MTOK, 2 * FF, DM, 0u}; pg8::StaticOrder S; S.init(MTOK, 2 * FF, F.G, (int)blockIdx.x);
        pg8::EpiSwiGLU E{F.HID, FF};
        pg8::gemm_phase<pg8::EpiSwiGLU, pg8::StaticOrder, true, true>(F.lds, g, S, E); }
    GRID_BAR();
    {   pg8::Gemm g{F.HID, F.WfoutT, MTOK, DM, FF, 0u}; pg8::StaticOrder S; S.init(MTOK, DM, F.G, (int)blockIdx.x);
        pg8::EpiResid E{F.out, F.out, F.modf + 10240};
        pg8::gemm_phase<pg8::EpiResid, pg8::StaticOrder, true, true>(F.lds, g, S, E); }
    GRID_BAR();
    final_norm_rows(F);
}

extern "C" void kernel_launch(void* const* d_in, const int* in_sizes, int n_in, void* d_out, int out_size, void* d_ws, size_t ws_size, hipStream_t stream) {
    static int grid = 0;
    if (grid == 0) {
        if (n_in != 16 || out_size != MTOK * DM || ws_size < WS_END) { fprintf(stderr, "kernel_launch: unexpected shapes (n_in %d out %d ws %zu)\n", n_in, out_size, ws_size); grid = -1; return; }
        int dev = 0, cus = 0, per_cu = 0;
        (void)hipGetDevice(&dev); (void)hipDeviceGetAttribute(&cus, hipDeviceAttributeMultiprocessorCount, dev);
        (void)hipFuncSetAttribute((const void*)fwd_megakernel, hipFuncAttributeMaxDynamicSharedMemorySize, LDS_BYTES);
        if (hipOccupancyMaxActiveBlocksPerMultiprocessor(&per_cu, (const void*)fwd_megakernel, NWAVES * 64, LDS_BYTES) != hipSuccess || per_cu < 1) per_cu = 1;
        (void)hipGetLastError();
        if (cus <= 0) cus = 256;
        grid = cus * per_cu; if (grid > 256) grid = 256;
    }
    if (grid < 0) return;
    (void)hipMemsetAsync((char*)d_ws + WS_MODFIX, 0, CTL_ZERO_BYTES, stream);
    Args a{};
    for (int i = 0; i < 16; ++i) a.in[i] = (const float*)d_in[i];
    a.out = (float*)d_out; a.ws = (unsigned char*)d_ws;
    void* kargs[] = {&a};
    hipError_t e = hipLaunchCooperativeKernel((const void*)fwd_megakernel, dim3(grid), dim3(NWAVES * 64), kargs, LDS_BYTES, stream);
    if (e != hipSuccess) fprintf(stderr, "cooperative launch failed: %s (grid %d)\n", hipGetErrorString(e), grid);
}
```
